# Optimizing an MI355X kernel written in HIP

```python
import jax, jax.numpy as jnp
from jax import lax
import numpy as np

D_MODEL = 1024
BATCH = 8
SEQ = 2048
DEPTH = 1
DEC_BATCH = 128
DEC_SEQ = 8
PAST_LEN = 16384
PAGE_SIZE = 128

MIX_WIDTH = D_MODEL
CONV_WIDTH = MIX_WIDTH // 2
CONV_GROUPS = 8
CONV_K = 3
M_WIDTH = MIX_WIDTH - CONV_WIDTH
M_HEADS = 4
HEAD_DIM = M_WIDTH // M_HEADS
N_META = 16
CHUNK = 128
EPS = 1e-6
PROJ_SPLITS = [CONV_WIDTH, CONV_WIDTH, CONV_WIDTH, CONV_WIDTH,
               M_WIDTH, M_WIDTH, M_WIDTH, M_WIDTH, M_WIDTH,
               M_HEADS, M_HEADS]
PROJ_WIDTH = sum(PROJ_SPLITS)

kernel_name = 'hymba_conv_mlstm_decode_step'


def rmsnorm(x, g):
    xf = x.astype(jnp.float32)
    y = xf * lax.rsqrt(jnp.mean(xf * xf, axis=-1, keepdims=True) + EPS)
    return (y * g.astype(jnp.float32)).astype(x.dtype)


def short_conv(u, buf, w):
    T = u.shape[1]
    ucat = jnp.concatenate([buf.astype(u.dtype), u], axis=1)
    y = w[0] * ucat[:, 0:T]
    for j in range(1, CONV_K):
        y = y + w[j] * ucat[:, j:j + T]
    return y, ucat[:, -(CONV_K - 1):]


def mlstm_chunk(q, k, v, ig, lf, c_prev, n_prev, m_prev):
    L = q.shape[2]
    b = jnp.cumsum(lf, axis=-1)
    causal = jnp.tril(jnp.ones((L, L), dtype=bool))
    log_d = jnp.where(causal, b[..., :, None] - b[..., None, :] + ig[..., None, :], -jnp.inf)
    m_inter = b + m_prev[..., None]
    m_t = jnp.maximum(m_inter, jnp.max(log_d, axis=-1))
    d = jnp.exp(log_d - m_t[..., None])
    inter = jnp.exp(m_inter - m_t)
    s = jnp.einsum('bhjd,bhsd->bhjs', q, k) * d
    num = jnp.einsum('bhjs,bhsv->bhjv', s, v) + inter[..., None] * jnp.einsum('bhjd,bhdv->bhjv', q, c_prev)
    den = jnp.sum(s, axis=-1) + inter * jnp.einsum('bhjd,bhd->bhj', q, n_prev)
    h = num / jnp.maximum(jnp.abs(den), jnp.exp(-m_t))[..., None]
    m_new = m_t[..., -1]
    w_last = jnp.exp(log_d[..., -1, :] - m_new[..., None])
    decay = inter[..., -1]
    c_new = decay[..., None, None] * c_prev + jnp.einsum('bhs,bhsd,bhsv->bhdv', w_last, k, v)
    n_new = decay[..., None] * n_prev + jnp.einsum('bhs,bhsd->bhd', w_last, k)
    return h, (c_new, n_new, m_new)


def mlstm_seq(q, k, v, ig, lf, state):
    B, H, T, D = q.shape
    nf = T // CHUNK
    hs = []
    if nf > 0:
        def to_chunks(a):
            a = a[:, :, :nf * CHUNK]
            a = a.reshape(a.shape[:2] + (nf, CHUNK) + a.shape[3:])
            return jnp.moveaxis(a, 2, 0)

        def body(carry, xs):
            qc, kc, vc, ic, fc = xs
            h, new = mlstm_chunk(qc, kc, vc, ic, fc, *carry)
            return new, h

        state, hc = lax.scan(body, state, tuple(to_chunks(a) for a in (q, k, v, ig, lf)))
        hs.append(jnp.moveaxis(hc, 0, 2).reshape(B, H, nf * CHUNK, D))
    if T % CHUNK:
        s0 = nf * CHUNK
        h, state = mlstm_chunk(q[:, :, s0:], k[:, :, s0:], v[:, :, s0:], ig[:, :, s0:], lf[:, :, s0:], *state)
        hs.append(h)
    h = hs[0] if len(hs) == 1 else jnp.concatenate(hs, axis=2)
    return h, state


def mixer_layer(x, conv_buf, c0, n0, m0, lead, norm_gain, w_in, conv_w, b_igate, b_fgate, mh_norm_gain, w_out):
    B, T, _ = x.shape
    xn = rmsnorm(x, norm_gain)
    proj = jnp.einsum('btd,dp->btp', xn, w_in)
    gb, gc, hc, zc, q, k, v, o, zm, ig, fg = jnp.split(proj, np.cumsum(PROJ_SPLITS)[:-1].tolist(), axis=-1)
    yc, conv_new = short_conv(gc * hc, conv_buf, conv_w)
    y_conv = gb * yc * jax.nn.silu(zc)
    def heads(a):
        return a.astype(jnp.float32).reshape(B, T, M_HEADS, HEAD_DIM).transpose(0, 2, 1, 3)
    qh, kh, vh = heads(q), heads(k) * (HEAD_DIM ** -0.5), heads(v)
    igh = (ig + b_igate).astype(jnp.float32).transpose(0, 2, 1)
    lfh = jax.nn.log_sigmoid((fg + b_fgate).astype(jnp.float32)).transpose(0, 2, 1)
    state = (c0.astype(jnp.float32), n0.astype(jnp.float32), m0.astype(jnp.float32))
    if lead > 0:
        h_lead, state = mlstm_chunk(qh[:, :, :lead], kh[:, :, :lead], vh[:, :, :lead],
                                    igh[:, :, :lead], lfh[:, :, :lead], *state)
        h_rest, state = mlstm_seq(qh[:, :, lead:], kh[:, :, lead:], vh[:, :, lead:],
                                  igh[:, :, lead:], lfh[:, :, lead:], state)
        h = jnp.concatenate([h_lead, h_rest], axis=2)
    else:
        h, state = mlstm_seq(qh, kh, vh, igh, lfh, state)
    h = h * lax.rsqrt(jnp.mean(h * h, axis=-1, keepdims=True) + EPS)
    h = h.transpose(0, 2, 1, 3).reshape(B, T, M_WIDTH) * mh_norm_gain.astype(jnp.float32)
    y_m = (h.astype(x.dtype) * jax.nn.sigmoid(o)) * jax.nn.silu(zm)
    out = jnp.einsum('btw,wd->btd', jnp.concatenate([y_conv, y_m], axis=-1), w_out)
    c_new, n_new, m_new = state
    return x + out, (conv_new, c_new.astype(x.dtype), n_new.astype(x.dtype), m_new.astype(x.dtype))


def setup_inputs(seed: int = 0) -> dict:
    key = jax.random.key(seed)
    ks = jax.random.split(key, 16)
    f32 = jnp.float32
    return {
        'x_prompt': jax.random.normal(ks[0], (BATCH, SEQ, D_MODEL), f32),
        'x_sample': jax.random.normal(ks[1], (DEC_BATCH, DEC_SEQ, D_MODEL), f32),
        'state_conv': jax.random.normal(ks[2], (DEC_BATCH, CONV_K - 1, CONV_WIDTH), f32),
        'state_mlstm_c': 0.5 * jax.random.normal(ks[3], (DEC_BATCH, M_HEADS, HEAD_DIM, HEAD_DIM), f32),
        'state_mlstm_n': 0.5 * jax.random.normal(ks[4], (DEC_BATCH, M_HEADS, HEAD_DIM), f32),
        'state_mlstm_m': jax.random.normal(ks[5], (DEC_BATCH, M_HEADS), f32),
        'meta_tokens': jax.random.normal(ks[6], (N_META, D_MODEL), f32),
        'norm_gain': 1.0 + 0.05 * jax.random.normal(ks[7], (D_MODEL,), f32),
        'w_in': jax.random.normal(ks[8], (D_MODEL, PROJ_WIDTH), f32) * D_MODEL ** -0.5,
        'conv_w': jax.random.normal(ks[9], (CONV_K, CONV_WIDTH), f32) * CONV_K ** -0.5,
        'b_igate': 0.1 * jax.random.normal(ks[10], (M_HEADS,), f32),
        'b_fgate': jnp.linspace(3.0, 6.0, M_HEADS, dtype=f32) + 0.1 * jax.random.normal(ks[11], (M_HEADS,), f32),
        'mh_norm_gain': 1.0 + 0.05 * jax.random.normal(ks[12], (M_WIDTH,), f32),
        'w_out': jax.random.normal(ks[13], (MIX_WIDTH, D_MODEL), f32) * MIX_WIDTH ** -0.5,
        'final_norm_gain': 1.0 + 0.05 * jax.random.normal(ks[14], (D_MODEL,), f32),
    }


def reference(x_prompt, x_sample, state_conv, state_mlstm_c, state_mlstm_n, state_mlstm_m,
              meta_tokens, norm_gain, w_in, conv_w, b_igate, b_fgate, mh_norm_gain, w_out, final_norm_gain):
    weights = (norm_gain, w_in, conv_w, b_igate, b_fgate, mh_norm_gain, w_out)
    Bp = x_prompt.shape[0]
    meta = jnp.broadcast_to(meta_tokens.astype(x_prompt.dtype)[None], (Bp, N_META, D_MODEL))
    xp = jnp.concatenate([meta, x_prompt], axis=1)
    conv0 = jnp.zeros((Bp, CONV_K - 1, CONV_WIDTH), x_prompt.dtype)
    c0 = jnp.zeros((Bp, M_HEADS, HEAD_DIM, HEAD_DIM), jnp.float32)
    n0 = jnp.zeros((Bp, M_HEADS, HEAD_DIM), jnp.float32)
    m0 = jnp.zeros((Bp, M_HEADS), jnp.float32)
    xs = x_sample
    cs, ns, ms, bs = state_mlstm_c, state_mlstm_n, state_mlstm_m, state_conv
    for _ in range(DEPTH):
        xp, (conv0, c0, n0, m0) = mixer_layer(xp, conv0, c0, n0, m0, N_META, *weights)
        xs, (bs, cs, ns, ms) = mixer_layer(xs, bs, cs, ns, ms, 0, *weights)
    y_prompt = rmsnorm(xp[:, N_META:], final_norm_gain)
    y_sample = rmsnorm(xs, final_norm_gain)
    return (y_prompt, y_sample, conv0, c0, n0, m0, bs, cs, ns, ms)
```

```cpp
#include <hip/hip_runtime.h>
#include <hip/hip_cooperative_groups.h>
#include <cstdio>
namespace cg = cooperative_groups;
namespace pg8 {
#define PG8_LAS __attribute__((address_space(3)))
typedef unsigned short bf16_t;
typedef short bf16x8 __attribute__((ext_vector_type(8)));
typedef float f32x4 __attribute__((ext_vector_type(4)));
typedef unsigned u32x4 __attribute__((ext_vector_type(4)));
constexpr int BM = 256, BK = 64, HALF = 128, HTB = HALF * BK * 2  , STAGE_BYTES = 8 * HTB, NXCD = 8, WGM = 8;

__host__ __device__ __forceinline__ int lds_byte(int r, int c) { const int st = (r >> 4) * 2 + (c >> 5), rr = r & 15, cc = c & 31, ob = rr * 64 + cc * 2; return st * 1024 + (ob ^ (((ob >> 9) & 1) << 5)); }
__host__ __device__ __forceinline__ void stage_rc(int b, int& R, int& C) { const int st = b / 1024, sb = b % 1024, swz = sb ^ (((sb >> 9) & 1) << 5); R = (st >> 1) * 16 + swz / 64; C = (st & 1) * 32 + (swz % 64) / 2; }
__host__ __device__ __forceinline__ int perm32(int rho) { const int n = rho >> 4, i = rho & 15; return 8 * (i >> 2) + 4 * n + (i & 3); }

struct Unit { int pm, pn; };
struct Gemm { const bf16_t* A; const bf16_t* Bt; int M, N, K; };

struct StaticOrder {
    int nM, nN, nwg, G, c;
    __host__ __device__ void init(int M, int N, int G_, int c_) { nM = M / BM; nN = N / BM; nwg = nM * nN; G = G_; c = c_; }
    __host__ __device__ bool next(int i, Unit& u) const {
        const long L = (long)i * G + c; if (L >= nwg) return false;
        int wgid = (int)L; { const int q = nwg / NXCD, r = nwg % NXCD, xcd = wgid % NXCD, off = wgid / NXCD; wgid = (xcd < r ? xcd * (q + 1) : r * (q + 1) + (xcd - r) * q) + off; }
        const int nig = WGM * nN, gid = wgid / nig, fm = gid * WGM, gsz = (nM - fm) < WGM ? (nM - fm) : WGM;
        u.pm = fm + ((wgid % nig) % gsz); u.pn = (wgid % nig) / gsz; return true;
    }
    __device__ __forceinline__ void a_ready(const Unit&) const {}
    __device__ __forceinline__ void done(const Unit&) const {}
};
__device__ __forceinline__ unsigned cvt_pk_bf16(float lo, float hi) { unsigned r; asm volatile("v_cvt_pk_bf16_f32 %0, %1, %2" : "=v"(r) : "v"(lo), "v"(hi)); return r; }
struct EpiBf16 {
    static constexpr bool PERM = true, AFTER_DRAIN = false;
    bf16_t* O; int ldc;
    __device__ __forceinline__ void operator()(const f32x4 (&acc)[2][2][4][2], const Unit& u, int wr, int wc, int fr, int fq) const {
        const int row0 = u.pm * BM + wr * 64 + fr, col0 = u.pn * BM + wc * 32 + 8 * fq;
#pragma unroll
        for (int ai = 0; ai < 2; ++ai)
#pragma unroll
            for (int m = 0; m < 4; ++m) { bf16_t* rowp = O + (size_t)(row0 + ai * HALF + m * 16) * ldc + col0;
#pragma unroll
                for (int bj = 0; bj < 2; ++bj) { const f32x4 v0 = acc[ai][bj][m][0], v1 = acc[ai][bj][m][1];
                    u32x4 w; w.x = cvt_pk_bf16(v0[0], v0[1]); w.y = cvt_pk_bf16(v0[2], v0[3]); w.z = cvt_pk_bf16(v1[0], v1[1]); w.w = cvt_pk_bf16(v1[2], v1[3]);
                    *(u32x4*)(rowp + bj * HALF) = w; } }
    }
};
struct EpiRes {
    static constexpr bool PERM = false, AFTER_DRAIN = false;
    const float* xp; const float* xs; float* out; float* rowss;
    __device__ __forceinline__ void operator()(const f32x4 (&acc)[2][2][4][2], const Unit& u, int wr, int wc, int fr, int fq) const {
        const int row0 = u.pm * BM + wr * 64 + fr, col0 = u.pn * BM + wc * 32 + 4 * fq;
#pragma unroll
        for (int ai = 0; ai < 2; ++ai)
#pragma unroll
            for (int m = 0; m < 4; ++m) { const int r = row0 + ai * HALF + m * 16;
                const float* xrow = (r < 16384) ? xp + (size_t)r * 1024 : xs + (size_t)(r - 16384) * 1024; float* orow = out + (size_t)r * 1024; float ss = 0.f;
#pragma unroll
                for (int bj = 0; bj < 2; ++bj)
#pragma unroll
                    for (int n = 0; n < 2; ++n) { const int c = col0 + bj * HALF + n * 16; const f32x4 v = acc[ai][bj][m][n] + *(const f32x4*)(xrow + c); *(f32x4*)(orow + c) = v;
                        ss += (v[0] * v[0] + v[1] * v[1]) + (v[2] * v[2] + v[3] * v[3]); }
                ss += __shfl_xor(ss, 16); ss += __shfl_xor(ss, 32);
                if (fq == 0) __hip_atomic_fetch_add(rowss + r, ss, __ATOMIC_RELAXED, __HIP_MEMORY_SCOPE_AGENT);
                asm volatile("" ::: "memory"); }
    }
};

template <class Epi, class Sched, bool STAMP = false>
__device__ __forceinline__ void gemm_phase(PG8_LAS unsigned char* lds, const Gemm g, const Sched& S, const Epi& E, unsigned long long* stamps) {
    const int tid = threadIdx.x, wid = __builtin_amdgcn_readfirstlane(tid >> 6), lane = tid & 63, wr = wid >> 2, wc = wid & 3, fr = lane & 15, fq = lane >> 4;
    const int K = g.K, nt = K / BK;
    int ts_lo = 0, ts_hi = 0, nts = 0; const unsigned long long rt_entry = STAMP ? (unsigned long long)wall_clock64() : 0ull;
#define PG8_STAMP() do { if (STAMP && wid == 0 && nts < 64) { const unsigned long long _c = (unsigned long long)clock64(); \
        ts_lo = (lane == nts) ? (int)(unsigned)_c : ts_lo; ts_hi = (lane == nts) ? (int)(unsigned)(_c >> 32) : ts_hi; ++nts; } } while (0)
    PG8_STAMP();
    unsigned voffA[2], voffB[2];
#pragma unroll
    for (int i = 0; i < 2; ++i) { int R, C; stage_rc(tid * 16 + i * 8192, R, C); const int Rb = Epi::PERM ? ((R & ~31) + perm32(R & 31)) : R;
        voffA[i] = (unsigned)(R * K + C) * 2u; voffB[i] = (unsigned)(Rb * K + C) * 2u; }
    const size_t kstep = (size_t)(BK * 2);
    const size_t hstep = (size_t)HALF * K * 2;
    const size_t tstep = 2 * hstep;
    const unsigned ldsw = (unsigned)wid * 1024u;
    const int aoff = lds_byte(wr * 64 + fr, fq * 8), boff = lds_byte(wc * 32 + fr, fq * 8);
#define PG8_SA(b, h) (((b) * 2 + (h)) * HTB)
#define PG8_SB(b, h) ((4 + (b) * 2 + (h)) * HTB)
#define PG8_STAGE(bufoff, gbase, voff) do { _Pragma("unroll") for (int _i = 0; _i < 2; ++_i) \
        __builtin_amdgcn_global_load_lds((const unsigned*)((const char*)(gbase) + (voff)[_i]), (PG8_LAS unsigned*)(lds + (bufoff) + ldsw + _i * 8192), 16, 0, 0); } while (0)
#define PG8_LDA(dst, b, h) do { _Pragma("unroll") for (int m = 0; m < 4; ++m) _Pragma("unroll") for (int k = 0; k < 2; ++k) dst[m][k] = *(const PG8_LAS bf16x8*)(lds + PG8_SA(b, h) + aoff + m * 2048 + k * 1024); } while (0)
#define PG8_LDB(dst, b, h) do { _Pragma("unroll") for (int n = 0; n < 2; ++n) _Pragma("unroll") for (int k = 0; k < 2; ++k) dst[n][k] = *(const PG8_LAS bf16x8*)(lds + PG8_SB(b, h) + boff + n * 2048 + k * 1024); } while (0)
#define PG8_MMA(ai, bj, At, Bt) do { __builtin_amdgcn_s_setprio(1); _Pragma("unroll") for (int m = 0; m < 4; ++m) _Pragma("unroll") for (int n = 0; n < 2; ++n) _Pragma("unroll") for (int k = 0; k < 2; ++k) \
        acc[ai][bj][m][n] = __builtin_amdgcn_mfma_f32_16x16x32_bf16(Bt[n][k], At[m][k], acc[ai][bj][m][n], 0, 0, 0); __builtin_amdgcn_s_setprio(0); } while (0)
#define PG8_WAIT_V(n) asm volatile("s_waitcnt vmcnt(" #n ")" ::: "memory")
#define PG8_WAIT_L(n) asm volatile("s_waitcnt lgkmcnt(" #n ")" ::: "memory")
#define PG8_BAR __builtin_amdgcn_s_barrier()
#define PG8_SCHED __builtin_amdgcn_sched_barrier(0)
    Unit cur, nxt; int ui = 0;
    if (!S.next(0, cur)) return;
    f32x4 acc[2][2][4][2];
#pragma unroll
    for (int a = 0; a < 2; ++a)
#pragma unroll
        for (int b = 0; b < 2; ++b)
#pragma unroll
            for (int m = 0; m < 4; ++m)
#pragma unroll
                for (int n = 0; n < 2; ++n) acc[a][b][m][n] = (f32x4){0.f, 0.f, 0.f, 0.f};
    bf16x8 At[4][2], B0[2][2], B1[2][2];
    const char* cA = (const char*)g.A + (size_t)cur.pm * tstep; const char* cB = (const char*)g.Bt + (size_t)cur.pn * tstep;
    S.a_ready(cur);
    PG8_STAGE(PG8_SB(0, 0), cB, voffB); PG8_STAGE(PG8_SA(0, 0), cA, voffA); PG8_STAGE(PG8_SB(0, 1), cB + hstep, voffB); PG8_STAGE(PG8_SA(0, 1), cA + hstep, voffA);
    if (wr == 1) PG8_BAR;
    PG8_WAIT_V(4); PG8_BAR;
    PG8_STAGE(PG8_SB(1, 0), cB + kstep, voffB); PG8_STAGE(PG8_SA(1, 0), cA + kstep, voffA); PG8_STAGE(PG8_SB(1, 1), cB + hstep + kstep, voffB);
    PG8_WAIT_V(6); PG8_BAR;
    PG8_STAMP();
    for (;;) {
        const bool has_next = S.next(ui + 1, nxt);
        const char* nA = has_next ? (const char*)g.A + (size_t)nxt.pm * tstep : cA; const char* nB = has_next ? (const char*)g.Bt + (size_t)nxt.pn * tstep : cB;
        for (int t = 0; t < nt; t += 2) {
            const bool last = (t == nt - 2);
            const char* a1 = cA + (size_t)(t + 1) * kstep;
            const char* a2 = last ? nA : cA + (size_t)(t + 2) * kstep; const char* b2 = last ? nB : cB + (size_t)(t + 2) * kstep;
            const char* a3 = a2 + kstep; const char* b3 = b2 + kstep;
            if (last && has_next) S.a_ready(nxt);
            PG8_LDB(B0, 0, 0); PG8_SCHED; PG8_LDA(At, 0, 0); PG8_STAGE(PG8_SA(1, 1), a1 + hstep, voffA);
            PG8_WAIT_L(8); PG8_BAR; PG8_WAIT_L(0); PG8_MMA(0, 0, At, B0); PG8_BAR; PG8_SCHED;
            PG8_LDB(B1, 0, 1); PG8_STAGE(PG8_SB(0, 0), b2, voffB);
            PG8_BAR; PG8_WAIT_L(0); PG8_MMA(0, 1, At, B1); PG8_BAR;
            PG8_LDA(At, 0, 1); PG8_STAGE(PG8_SA(0, 0), a2, voffA);
            PG8_BAR; PG8_WAIT_L(0); PG8_MMA(1, 0, At, B0); PG8_BAR; PG8_SCHED;
            PG8_STAGE(PG8_SB(0, 1), b2 + hstep, voffB);
            PG8_WAIT_V(6); PG8_BAR; PG8_MMA(1, 1, At, B1); PG8_BAR;
            PG8_LDB(B0, 1, 0); PG8_SCHED; PG8_LDA(At, 1, 0); PG8_STAGE(PG8_SA(0, 1), a2 + hstep, voffA);
            PG8_WAIT_L(8); PG8_BAR; PG8_WAIT_L(0); PG8_MMA(0, 0, At, B0); PG8_BAR; PG8_SCHED;
            PG8_LDB(B1, 1, 1); PG8_STAGE(PG8_SB(1, 0), b3, voffB);
            PG8_BAR; PG8_WAIT_L(0); PG8_MMA(0, 1, At, B1); PG8_BAR;
            PG8_LDA(At, 1, 1); PG8_STAGE(PG8_SA(1, 0), a3, voffA);
            PG8_BAR; PG8_WAIT_L(0); PG8_MMA(1, 0, At, B0); PG8_BAR; PG8_SCHED;
            PG8_STAGE(PG8_SB(1, 1), b3 + hstep, voffB);
            PG8_WAIT_V(6); PG8_BAR; PG8_MMA(1, 1, At, B1); PG8_BAR;
        }
        PG8_STAMP();
        if constexpr (!Epi::AFTER_DRAIN) { E(acc, cur, wr, wc, fr, fq); S.done(cur); }
        PG8_STAMP();
        if (!has_next) break;
#pragma unroll
        for (int a = 0; a < 2; ++a)
#pragma unroll
            for (int b = 0; b < 2; ++b)
#pragma unroll
                for (int m = 0; m < 4; ++m)
#pragma unroll
                    for (int n = 0; n < 2; ++n) acc[a][b][m][n] = (f32x4){0.f, 0.f, 0.f, 0.f};
        cur = nxt; cA = nA; cB = nB; ++ui;
    }
    PG8_WAIT_V(0);
    if (wr == 0) PG8_BAR;
    PG8_BAR;
    if constexpr (Epi::AFTER_DRAIN) { E.fused(acc, cur, wr, wc, fr, fq, lds, wid, lane); S.done(cur); }
    PG8_STAMP();
    if (STAMP && wid == 0) { stamps[lane] = lane < nts ? (((unsigned long long)(unsigned)ts_hi << 32) | (unsigned)ts_lo) : 0ull;
        if (lane == 62) stamps[62] = rt_entry; if (lane == 63) stamps[63] = (unsigned long long)wall_clock64(); }
#undef PG8_STAMP
#undef PG8_SA
#undef PG8_SB
#undef PG8_STAGE
#undef PG8_LDA
#undef PG8_LDB
#undef PG8_MMA
#undef PG8_WAIT_V
#undef PG8_WAIT_L
#undef PG8_BAR
#undef PG8_SCHED
}
}

#define LAS __attribute__((address_space(3)))
typedef unsigned short bf16_t;
typedef short bf16x8 __attribute__((ext_vector_type(8)));
typedef short s16x4 __attribute__((ext_vector_type(4)));
typedef float f32x4 __attribute__((ext_vector_type(4)));
typedef unsigned u32x4 __attribute__((ext_vector_type(4)));
typedef unsigned u32x2 __attribute__((ext_vector_type(2)));

constexpr int DM = 1024, TP = 2064, NPROW = 8 * TP  , NROW = NPROW + 1024  , MPAD = 17664, NPROJ = 4608, LDW = 4616, MOUT = 17408;
constexpr int NCH = 17;
constexpr int RS = 272;
constexpr int TILE_B = 128 * RS;
constexpr int LDS_BYTES = 147456;
constexpr float KSCALE = 0.08838834764831845f;
constexpr float EPS = 1e-6f;
constexpr size_t O_YS = 16777216, O_CONVP = 17825792, O_CP = 17833984, O_NP = 18358272, O_MP = 18362368, O_CONVS = 18362400, O_CS = 18493472, O_NS = 26882080, O_MS = 26947616;
constexpr size_t W_WTIN = 0, W_WTOUT = 9437184, W_XN = 11534336, W_G = 47710208, W_A = 48271360, W_M = W_A + 264192, W_B = W_M + 264192, W_MLOC = 49063936, W_NLOC = 49068032,
                 W_NST = 49346560, W_ROWSS = 49625088, W_PROJ = 49694720, W_LLOC = 212486144, W_CST = 248137728, W_END = 265963520;

struct Params {
    const float *x_prompt, *x_sample, *st_conv, *st_c, *st_n, *st_m, *meta, *norm_gain, *w_in, *conv_w, *b_ig, *b_fg, *mh_gain, *w_out, *fin_gain;
    float* out; unsigned char* ws;
};

__device__ __forceinline__ float wave_sum(float v) {
#pragma unroll
    for (int o = 1; o < 64; o <<= 1) v += __shfl_xor(v, o);
    return v;
}
__device__ __forceinline__ float wave_max(float v) {
#pragma unroll
    for (int o = 1; o < 64; o <<= 1) v = fmaxf(v, __shfl_xor(v, o));
    return v;
}
__device__ __forceinline__ unsigned f2bf(float f) { unsigned u = __float_as_uint(f); return (u + 0x7fffu + ((u >> 16) & 1u)) >> 16; }
__device__ __forceinline__ unsigned pk2(float lo, float hi) { return f2bf(lo) | (f2bf(hi) << 16); }
__device__ __forceinline__ float bf2f(unsigned b) { return __uint_as_float(b << 16); }
__device__ __forceinline__ float bflo(unsigned w) { return __uint_as_float(w << 16); }
__device__ __forceinline__ float bfhi(unsigned w) { return __uint_as_float(w & 0xffff0000u); }
__device__ __forceinline__ float sigmoidf_(float x) { return 1.f / (1.f + __expf(-x)); }
__device__ __forceinline__ float siluf_(float x) { return x / (1.f + __expf(-x)); }
__device__ __forceinline__ bf16x8 tr2(LAS unsigned char* p0) {
    const s16x4 lo = __builtin_amdgcn_ds_read_tr16_b64_v4i16((LAS s16x4*)p0);
    const s16x4 hi = __builtin_amdgcn_ds_read_tr16_b64_v4i16((LAS s16x4*)(p0 + 4 * RS));
    return __builtin_shufflevector(lo, hi, 0, 1, 2, 3, 4, 5, 6, 7);
}

__device__ __forceinline__ void p0_transpose_item(const float* W, int ldw, int nblk, bf16_t* WT, int K, LAS float* scr, int item, int lane) {
    const int kb = item / nblk, nb = item % nblk, k0 = 64 * kb, n0 = 32 * nb;
#pragma unroll 8
    for (int i = 0; i < 32; ++i) { const int kk = 2 * i + (lane >> 5); scr[kk * 33 + (lane & 31)] = W[(size_t)(k0 + kk) * ldw + n0 + (lane & 31)]; }
    asm volatile("s_waitcnt lgkmcnt(0)" ::: "memory");
    const int c = lane & 7;
#pragma unroll
    for (int j = 0; j < 4; ++j) { const int n = (lane >> 3) + 8 * j; const LAS float* s = scr + (8 * c) * 33 + n;
        u32x4 o; o.x = pk2(s[0 * 33], s[1 * 33]); o.y = pk2(s[2 * 33], s[3 * 33]); o.z = pk2(s[4 * 33], s[5 * 33]); o.w = pk2(s[6 * 33], s[7 * 33]);
        *(u32x4*)(WT + (size_t)(n0 + n) * K + k0 + 8 * c) = o; }
    asm volatile("s_waitcnt lgkmcnt(0)" ::: "memory");
}

__device__ __forceinline__ void phase0(const Params& p, LAS unsigned char* lds, int tid, int lane, int wave) {
    LAS float* gwl = (LAS float*)lds;
    LAS float* scr = (LAS float*)(lds + 32768) + wave * (64 * 33);
    for (int i = tid; i < 8192; i += 512) { const int k = i >> 3, j = i & 7; gwl[j * 1024 + k] = p.w_in[(size_t)k * LDW + NPROJ + j]; }
    __syncthreads();
    const int gw = blockIdx.x * 8 + wave, NGW = gridDim.x * 8;
    float* rowss = (float*)(p.ws + W_ROWSS);
    for (int i = blockIdx.x * 512 + tid; i < MOUT; i += gridDim.x * 512) rowss[i] = 0.f;
    bf16_t* XN = (bf16_t*)(p.ws + W_XN);
    for (int i = blockIdx.x * 512 + tid; i < 16384; i += gridDim.x * 512) ((u32x4*)(XN + (size_t)NROW * 1024))[i] = (u32x4){0u, 0u, 0u, 0u};
    for (int it = gw; it < 2304 + 512; it += NGW) {
        if (it < 2304) p0_transpose_item(p.w_in, LDW, 144, (bf16_t*)(p.ws + W_WTIN), 1024, scr, it, lane);
        else p0_transpose_item(p.w_out, 1024, 32, (bf16_t*)(p.ws + W_WTOUT), 1024, scr, it - 2304, lane);
    }
    float* G = (float*)(p.ws + W_G);
    for (int r = gw; r < NROW; r += NGW) {
        const float* src;
        if (r < NPROW) { const int b = r / TP, t = r - b * TP; src = (t < 16) ? p.meta + t * 1024 : p.x_prompt + ((size_t)b * 2048 + (t - 16)) * 1024; }
        else src = p.x_sample + (size_t)(r - NPROW) * 1024;
        f32x4 v[4]; float ss = 0.f;
#pragma unroll
        for (int j = 0; j < 4; ++j) { v[j] = ((const f32x4*)src)[lane + 64 * j]; ss += (v[j][0] * v[j][0] + v[j][1] * v[j][1]) + (v[j][2] * v[j][2] + v[j][3] * v[j][3]); }
        const float rstd = rsqrtf(wave_sum(ss) * (1.f / 1024.f) + EPS);
#pragma unroll
        for (int j = 0; j < 4; ++j) { const f32x4 g = ((const f32x4*)p.norm_gain)[lane + 64 * j]; v[j] = v[j] * rstd * g;
            u32x2 o; o.x = pk2(v[j][0], v[j][1]); o.y = pk2(v[j][2], v[j][3]); ((u32x2*)(XN + (size_t)r * 1024))[lane + 64 * j] = o; }
        float ga[8];
#pragma unroll
        for (int q = 0; q < 8; ++q) { float s = 0.f;
#pragma unroll
            for (int j = 0; j < 4; ++j) { const f32x4 w = *(const LAS f32x4*)(gwl + q * 1024 + 4 * (lane + 64 * j)); s += (v[j][0] * w[0] + v[j][1] * w[1]) + (v[j][2] * w[2] + v[j][3] * w[3]); }
            ga[q] = wave_sum(s); }
        if (lane == 0) {
#pragma unroll
            for (int h = 0; h < 4; ++h) { G[(size_t)r * 8 + h] = ga[h] + p.b_ig[h]; const float x = ga[4 + h] + p.b_fg[h]; G[(size_t)r * 8 + 4 + h] = fminf(x, 0.f) - log1pf(expf(-fabsf(x))); }
        }
    }
}

__device__ __forceinline__ void seq_scan(const Params& p, int bh, int lane) {
    const float* G = (const float*)(p.ws + W_G); float* A = (float*)(p.ws + W_A) + bh * TP; float* M = (float*)(p.ws + W_M) + bh * TP; float* Bc = (float*)(p.ws + W_B) + bh * TP;
    const int b = bh >> 2, h = bh & 3; float cB = 0.f, cM = 0.f;
    for (int it = 0; it < 33; ++it) { const int t = it * 64 + lane; const bool valid = t < TP; const size_t row = (size_t)b * TP + (valid ? t : 0);
        const float lf = valid ? G[row * 8 + 4 + h] : 0.f, ig = valid ? G[row * 8 + h] : -INFINITY;
        float s = lf;
#pragma unroll
        for (int o = 1; o < 64; o <<= 1) { const float n = __shfl_up(s, o); if (lane >= o) s += n; }
        const float Bt = cB + s; const float a = valid ? ig - Bt : -INFINITY; float m = a;
#pragma unroll
        for (int o = 1; o < 64; o <<= 1) { const float n = __shfl_up(m, o); if (lane >= o) m = fmaxf(m, n); }
        const float Mt = fmaxf(cM, m);
        if (valid) { A[t] = a; M[t] = Mt; Bc[t] = Bt; }
        cB = __shfl(Bt, 63); cM = __shfl(Mt, 63); }
}

__device__ __forceinline__ void p2_chunk_local(const Params& p, LAS unsigned char* lds, int it, int tid, int lane, int wave) {
    LAS unsigned char* Ks = lds; LAS unsigned char* Vs = lds + TILE_B; LAS float* wl = (LAS float*)(lds + 2 * TILE_B);
    const int bh = it / NCH, c = it - bh * NCH, b = bh >> 2, h = bh & 3, t0 = c ? 16 + 128 * (c - 1) : 0, L = c ? 128 : 16;
    const float* Aseq = (const float*)(p.ws + W_A) + bh * TP + t0;
    const float a0 = lane < L ? Aseq[lane] : -INFINITY, a1 = lane + 64 < L ? Aseq[lane + 64] : -INFINITY;
    const float Mloc = wave_max(fmaxf(a0, a1));
    if (wave == 0) { wl[lane] = lane < L ? __expf(a0 - Mloc) : 0.f; wl[lane + 64] = lane + 64 < L ? __expf(a1 - Mloc) : 0.f; }
    const bf16_t* PROJ = (const bf16_t*)(p.ws + W_PROJ);
#pragma unroll
    for (int i = 0; i < 4; ++i) { const int idx = tid + 512 * i, s = idx >> 4, ch = idx & 15;
        const bf16_t* pr = PROJ + (size_t)(b * TP + t0 + s) * NPROJ + h * 128 + ch * 8;
        const u32x4 kv = *(const u32x4*)(pr + 2560); u32x4 vv = *(const u32x4*)(pr + 3072);
        const float w = s < L ? __expf(Aseq[s] - Mloc) : 0.f;
        vv.x = pk2(bflo(vv.x) * w, bfhi(vv.x) * w); vv.y = pk2(bflo(vv.y) * w, bfhi(vv.y) * w); vv.z = pk2(bflo(vv.z) * w, bfhi(vv.z) * w); vv.w = pk2(bflo(vv.w) * w, bfhi(vv.w) * w);
        *(LAS u32x4*)(Ks + s * RS + ch * 16) = kv; *(LAS u32x4*)(Vs + s * RS + ch * 16) = vv; }
    __syncthreads();
    const int fr = lane & 15, g = lane >> 4, q = fr >> 2, pp = fr & 3;
    bf16x8 af[4];
#pragma unroll
    for (int ks = 0; ks < 4; ++ks) af[ks] = tr2(Vs + (32 * ks + 8 * g + q) * RS + (16 * wave + 4 * pp) * 2);
    float* LT = (float*)(p.ws + W_LLOC) + (size_t)it * 16384;
#pragma unroll
    for (int nb = 0; nb < 8; ++nb) { f32x4 acc = {0.f, 0.f, 0.f, 0.f};
#pragma unroll
        for (int ks = 0; ks < 4; ++ks) { const bf16x8 bk = tr2(Ks + (32 * ks + 8 * g + q) * RS + (16 * nb + 4 * pp) * 2); acc = __builtin_amdgcn_mfma_f32_16x16x32_bf16(af[ks], bk, acc, 0, 0, 0); }
#pragma unroll
        for (int r = 0; r < 4; ++r) LT[(16 * wave + 4 * g + r) * 128 + 16 * nb + fr] = acc[r] * KSCALE; }
    if (tid < 128) { float s = 0.f;
        for (int ss = 0; ss < 128; ++ss) s += wl[ss] * bf2f(*(const LAS bf16_t*)(Ks + ss * RS + tid * 2));
        ((float*)(p.ws + W_NLOC))[(size_t)it * 128 + tid] = s * KSCALE; }
    if (tid == 0) ((float*)(p.ws + W_MLOC))[it] = Mloc;
    __syncthreads();
}

__device__ __forceinline__ void ld8(const bf16_t* src, float (&o)[8]) { const u32x4 r = *(const u32x4*)src; o[0] = bflo(r.x); o[1] = bfhi(r.x); o[2] = bflo(r.y); o[3] = bfhi(r.y); o[4] = bflo(r.z); o[5] = bfhi(r.z); o[6] = bflo(r.w); o[7] = bfhi(r.w); }
__device__ __forceinline__ void ld8f(const float* src, float (&o)[8]) { const f32x4 a = *(const f32x4*)src, b = *(const f32x4*)(src + 4); o[0] = a[0]; o[1] = a[1]; o[2] = a[2]; o[3] = a[3]; o[4] = b[0]; o[5] = b[1]; o[6] = b[2]; o[7] = b[3]; }
__device__ __forceinline__ void st8f(float* dst, const float (&o)[8]) { *(f32x4*)dst = (f32x4){o[0], o[1], o[2], o[3]}; *(f32x4*)(dst + 4) = (f32x4){o[4], o[5], o[6], o[7]}; }
__device__ __forceinline__ void p2_conv(const Params& p, int widx, int lane) {
    const bf16_t* PROJ = (const bf16_t*)(p.ws + W_PROJ); bf16_t* YC = (bf16_t*)(p.ws + W_XN);
    const int c0 = lane * 8; const bool sample = widx >= 520;
    int rowbase, t0, len, sb = 0, b = 0;
    if (!sample) { b = widx / 65; const int seg = widx - b * 65; t0 = 32 * seg; len = (TP - t0) < 32 ? (TP - t0) : 32; rowbase = b * TP; }
    else { sb = widx - 520; t0 = 0; len = 8; rowbase = NPROW + sb * 8; }
    float w0[8], w1[8], w2[8], u1[8], u2[8];
    ld8f(p.conv_w + c0, w0); ld8f(p.conv_w + 512 + c0, w1); ld8f(p.conv_w + 1024 + c0, w2);
    if (sample) { ld8f(p.st_conv + (size_t)sb * 1024 + c0, u2); ld8f(p.st_conv + (size_t)sb * 1024 + 512 + c0, u1); }
    else if (t0 == 0) {
#pragma unroll
        for (int i = 0; i < 8; ++i) { u1[i] = 0.f; u2[i] = 0.f; } }
    else { float gc[8], hc[8];
        const bf16_t* pr = PROJ + (size_t)(rowbase + t0 - 2) * NPROJ + c0; ld8(pr + 512, gc); ld8(pr + 1024, hc);
#pragma unroll
        for (int i = 0; i < 8; ++i) u2[i] = gc[i] * hc[i];
        pr += NPROJ; ld8(pr + 512, gc); ld8(pr + 1024, hc);
#pragma unroll
        for (int i = 0; i < 8; ++i) u1[i] = gc[i] * hc[i]; }
    for (int tt = 0; tt < len; ++tt) { const int t = t0 + tt; const bf16_t* pr = PROJ + (size_t)(rowbase + t) * NPROJ + c0;
        float gb[8], gc[8], hc[8], zc[8], u[8]; ld8(pr, gb); ld8(pr + 512, gc); ld8(pr + 1024, hc); ld8(pr + 1536, zc);
        u32x4 o; float y[8];
#pragma unroll
        for (int i = 0; i < 8; ++i) { u[i] = gc[i] * hc[i]; const float yc = w0[i] * u2[i] + w1[i] * u1[i] + w2[i] * u[i]; y[i] = gb[i] * yc * siluf_(zc[i]); }
        o.x = pk2(y[0], y[1]); o.y = pk2(y[2], y[3]); o.z = pk2(y[4], y[5]); o.w = pk2(y[6], y[7]);
        if (sample) { *(u32x4*)(YC + (size_t)(16384 + sb * 8 + t) * 1024 + c0) = o; if (t >= 6) st8f(p.out + O_CONVS + (size_t)sb * 1024 + (t - 6) * 512 + c0, u); }
        else { if (t >= 16) *(u32x4*)(YC + (size_t)(b * 2048 + t - 16) * 1024 + c0) = o; if (t >= TP - 2) st8f(p.out + O_CONVP + (size_t)b * 1024 + (t - (TP - 2)) * 512 + c0, u); }
#pragma unroll
        for (int i = 0; i < 8; ++i) { u2[i] = u1[i]; u1[i] = u[i]; } }
}

__device__ __forceinline__ void p2_sample(const Params& p, LAS unsigned char* lds, int si, int tid, int lane, int wave) {
    LAS float* ql = (LAS float*)lds; LAS float* kl = ql + 1024; LAS float* vl = kl + 1024; LAS float* sdl = vl + 1024; LAS float* qnl = sdl + 64; LAS float* red = qnl + 64;
    const int sb = si >> 2, h = si & 3, rowbase = NPROW + sb * 8; const size_t sh = (size_t)sb * 4 + h;
    const float* G = (const float*)(p.ws + W_G); const bf16_t* PROJ = (const bf16_t*)(p.ws + W_PROJ); bf16_t* YC = (bf16_t*)(p.ws + W_XN);
    const float mprev = p.st_m[sh];
    float a[8], M[8], bc[8];
    { float run = 0.f, Mr = mprev;
#pragma unroll
      for (int t = 0; t < 8; ++t) { run += G[(size_t)(rowbase + t) * 8 + 4 + h]; bc[t] = run; a[t] = G[(size_t)(rowbase + t) * 8 + h] - run; Mr = fmaxf(Mr, a[t]); M[t] = Mr; } }
    float Mt = M[0], bt = bc[0];
#pragma unroll
    for (int t = 1; t < 8; ++t) { Mt = (wave == t) ? M[t] : Mt; bt = (wave == t) ? bc[t] : bt; }
    if (tid < 384) { const int mat = tid >> 7, rem = tid & 127, t = rem >> 4, ch = rem & 15; float x[8];
        ld8(PROJ + (size_t)(rowbase + t) * NPROJ + 2048 + mat * 512 + h * 128 + ch * 8, x);
        const float sc = (mat == 1) ? KSCALE : 1.f; LAS float* dst = ql + mat * 1024 + t * 128 + ch * 8;
        *(LAS f32x4*)dst = (f32x4){x[0] * sc, x[1] * sc, x[2] * sc, x[3] * sc}; *(LAS f32x4*)(dst + 4) = (f32x4){x[4] * sc, x[5] * sc, x[6] * sc, x[7] * sc}; }
    __syncthreads();
    const float* nprev = p.st_n + sh * 128;
    { const int t = wave; const float q0 = ql[t * 128 + lane], q1 = ql[t * 128 + lane + 64];
      const float qn = wave_sum(q0 * nprev[lane] + q1 * nprev[lane + 64]);
#pragma unroll
      for (int s = 0; s < 8; ++s) { const float d = wave_sum(q0 * kl[s * 128 + lane] + q1 * kl[s * 128 + lane + 64]); const float val = (s <= t) ? d * __expf(a[s] - Mt) : 0.f; if (lane == 0) sdl[t * 8 + s] = val; }
      if (lane == 0) qnl[t] = qn; }
    __syncthreads();
    const float decay = __expf(mprev - M[7]);
    float wS[8];
#pragma unroll
    for (int s = 0; s < 8; ++s) wS[s] = __expf(a[s] - M[7]);
    { const int dg = tid >> 5, v4 = tid & 31; const size_t coff = (sh * 128 + dg * 8) * 128 + v4 * 4;
      const float* Cp = p.st_c + coff; float* Cn = p.out + O_CS + coff;
      f32x4 Cv[8];
#pragma unroll
      for (int i = 0; i < 8; ++i) Cv[i] = *(const f32x4*)(Cp + i * 128);
#pragma unroll
      for (int t = 0; t < 8; ++t) { f32x4 pt = {0.f, 0.f, 0.f, 0.f};
#pragma unroll
          for (int i = 0; i < 8; ++i) pt += ql[t * 128 + dg * 8 + i] * Cv[i];
          *(LAS f32x4*)(red + (dg * 8 + t) * 128 + v4 * 4) = pt; }
#pragma unroll
      for (int i = 0; i < 8; ++i) { f32x4 cn = decay * Cv[i];
#pragma unroll
          for (int s = 0; s < 8; ++s) cn += (wS[s] * kl[s * 128 + dg * 8 + i]) * *(const LAS f32x4*)(vl + s * 128 + v4 * 4);
          *(f32x4*)(Cn + i * 128) = cn; } }
    __syncthreads();
    { const int t = wave; const float inter = __expf(mprev - Mt), mt = bt + Mt;
      float n0 = 0.f, n1 = 0.f;
#pragma unroll
      for (int dg = 0; dg < 16; ++dg) { n0 += red[(dg * 8 + t) * 128 + lane]; n1 += red[(dg * 8 + t) * 128 + lane + 64]; }
      n0 *= inter; n1 *= inter; float den = inter * qnl[t];
#pragma unroll
      for (int s = 0; s < 8; ++s) { const float sd = sdl[t * 8 + s]; n0 += sd * vl[s * 128 + lane]; n1 += sd * vl[s * 128 + lane + 64]; den += sd; }
      const float dd = fmaxf(fabsf(den), __expf(-mt)); const float h0 = n0 / dd, h1 = n1 / dd;
      const float sc = rsqrtf(wave_sum(h0 * h0 + h1 * h1) * (1.f / 128.f) + EPS);
      const bf16_t* pr = PROJ + (size_t)(rowbase + t) * NPROJ + h * 128;
      const float o0 = bf2f(pr[3584 + lane]), o1 = bf2f(pr[3584 + lane + 64]), z0 = bf2f(pr[4096 + lane]), z1 = bf2f(pr[4096 + lane + 64]);
      const float y0 = h0 * sc * p.mh_gain[h * 128 + lane] * sigmoidf_(o0) * siluf_(z0), y1 = h1 * sc * p.mh_gain[h * 128 + lane + 64] * sigmoidf_(o1) * siluf_(z1);
      bf16_t* yo = YC + (size_t)(16384 + sb * 8 + t) * 1024 + 512 + h * 128; yo[lane] = (bf16_t)f2bf(y0); yo[lane + 64] = (bf16_t)f2bf(y1); }
    if (tid < 128) { float nn = decay * nprev[tid];
#pragma unroll
        for (int s = 0; s < 8; ++s) nn += wS[s] * kl[s * 128 + tid];
        p.out[O_NS + sh * 128 + tid] = nn; }
    if (tid == 0) p.out[O_MS + sh] = bc[7] + M[7];
    __syncthreads();
}

__device__ __forceinline__ void phase3(const Params& p, int tid) {
    const float* Mall = (const float*)(p.ws + W_M); const float* MLOC = (const float*)(p.ws + W_MLOC);
    const float* LLOC = (const float*)(p.ws + W_LLOC); bf16_t* CST = (bf16_t*)(p.ws + W_CST);
    for (int e = blockIdx.x * 512 + tid; e < 32 * 4096; e += gridDim.x * 512) {
        const int bh = e >> 12, rem = e & 4095, v = rem >> 5, d4 = rem & 31; const float* Mseq = Mall + bh * TP;
        f32x4 st = {0.f, 0.f, 0.f, 0.f}; float Eprev = 0.f;
#pragma unroll
        for (int c = 0; c < NCH; ++c) { const size_t off = (size_t)(bh * NCH + c) * 16384 + v * 128 + d4 * 4;
            u32x2 o; o.x = pk2(st[0], st[1]); o.y = pk2(st[2], st[3]); *(u32x2*)(CST + off) = o;
            const float Ec = Mseq[c ? 16 + 128 * c - 1 : 15], Ml = MLOC[bh * NCH + c]; const f32x4 Lv = *(const f32x4*)(LLOC + off);
            st = __expf(Eprev - Ec) * st + __expf(Ml - Ec) * Lv; Eprev = Ec; }
#pragma unroll
        for (int j = 0; j < 4; ++j) p.out[O_CP + ((size_t)bh * 128 + d4 * 4 + j) * 128 + v] = st[j];
    }
    const float* NLOC = (const float*)(p.ws + W_NLOC); float* NST = (float*)(p.ws + W_NST);
    for (int e = blockIdx.x * 512 + tid; e < 32 * 128; e += gridDim.x * 512) {
        const int bh = e >> 7, d = e & 127; const float* Mseq = Mall + bh * TP; float st = 0.f, Eprev = 0.f;
        for (int c = 0; c < NCH; ++c) { const size_t off = (size_t)(bh * NCH + c) * 128 + d; NST[off] = st;
            const float Ec = Mseq[c ? 16 + 128 * c - 1 : 15], Ml = MLOC[bh * NCH + c];
            st = __expf(Eprev - Ec) * st + __expf(Ml - Ec) * NLOC[off]; Eprev = Ec; }
        p.out[O_NP + e] = st;
        if (d == 0) p.out[O_MP + bh] = ((const float*)(p.ws + W_B))[bh * TP + TP - 1] + Mseq[TP - 1];
    }
}

__device__ __forceinline__ void p4_chunk_out(const Params& p, LAS unsigned char* lds, int it, int tid, int lane, int wave) {
    LAS unsigned char* Qs = lds; LAS unsigned char* Ks = lds + TILE_B; LAS unsigned char* Vs = lds + 2 * TILE_B; LAS unsigned char* Cs = lds + 3 * TILE_B;
    LAS float* al = (LAS float*)(lds + 4 * TILE_B); LAS float* Ml = al + 128; LAS float* negm = Ml + 128; LAS float* nsl = negm + 128;
    const int bh = it >> 4, c = (it & 15) + 1, b = bh >> 2, h = bh & 3, t0 = 16 + 128 * (c - 1), rowbase = b * TP + t0;
    const bf16_t* PROJ = (const bf16_t*)(p.ws + W_PROJ); bf16_t* YC = (bf16_t*)(p.ws + W_XN);
    const bf16_t* CT = (const bf16_t*)(p.ws + W_CST) + (size_t)(bh * NCH + c) * 16384;
    const float* Mseq = (const float*)(p.ws + W_M) + bh * TP;
#pragma unroll
    for (int i = 0; i < 4; ++i) { const int idx = tid + 512 * i, s = idx >> 4, ch = idx & 15;
        const bf16_t* pr = PROJ + (size_t)(rowbase + s) * NPROJ + h * 128 + ch * 8;
        *(LAS u32x4*)(Qs + s * RS + ch * 16) = *(const u32x4*)(pr + 2048); *(LAS u32x4*)(Ks + s * RS + ch * 16) = *(const u32x4*)(pr + 2560);
        *(LAS u32x4*)(Vs + s * RS + ch * 16) = *(const u32x4*)(pr + 3072); *(LAS u32x4*)(Cs + s * RS + ch * 16) = *(const u32x4*)(CT + s * 128 + ch * 8); }
    if (tid < 128) { const float m = Mseq[t0 + tid]; al[tid] = ((const float*)(p.ws + W_A))[bh * TP + t0 + tid]; Ml[tid] = m; negm[tid] = -(((const float*)(p.ws + W_B))[bh * TP + t0 + tid] + m);
        nsl[tid] = ((const float*)(p.ws + W_NST))[(size_t)(bh * NCH + c) * 128 + tid]; }
    const float Eprev = Mseq[t0 - 1];
    __syncthreads();
    const int fr = lane & 15, g = lane >> 4, q = fr >> 2, pp = fr & 3, w = wave;
    bf16x8 aq[4];
#pragma unroll
    for (int ks = 0; ks < 4; ++ks) aq[ks] = *(const LAS bf16x8*)(Qs + (16 * w + fr) * RS + (32 * ks + 8 * g) * 2);
    f32x4 accn = {0.f, 0.f, 0.f, 0.f};
#pragma unroll
    for (int ks = 0; ks < 4; ++ks) { bf16x8 bn;
#pragma unroll
        for (int j = 0; j < 8; ++j) bn[j] = (fr == 0) ? (short)f2bf(nsl[32 * ks + 8 * g + j]) : (short)0;
        accn = __builtin_amdgcn_mfma_f32_16x16x32_bf16(aq[ks], bn, accn, 0, 0, 0); }
    float Mt[4], inter[4], dsum[4];
#pragma unroll
    for (int r = 0; r < 4; ++r) { Mt[r] = Ml[16 * w + 4 * g + r]; inter[r] = __expf(Eprev - Mt[r]); dsum[r] = 0.f; }
#pragma unroll
    for (int nb = 0; nb < 8; ++nb) { float sd[4] = {0.f, 0.f, 0.f, 0.f};
        if (nb <= w) { f32x4 s = {0.f, 0.f, 0.f, 0.f};
#pragma unroll
            for (int ks = 0; ks < 4; ++ks) { const bf16x8 bk = *(const LAS bf16x8*)(Ks + (16 * nb + fr) * RS + (32 * ks + 8 * g) * 2); s = __builtin_amdgcn_mfma_f32_16x16x32_bf16(aq[ks], bk, s, 0, 0, 0); }
            const float as = al[16 * nb + fr]; const int scol = 16 * nb + fr;
#pragma unroll
            for (int r = 0; r < 4; ++r) { const int trow = 16 * w + 4 * g + r; const float val = (scol <= trow) ? s[r] * KSCALE * __expf(as - Mt[r]) : 0.f; dsum[r] += val; sd[r] = val; } }
#pragma unroll
        for (int r = 0; r < 4; ++r) *(LAS bf16_t*)(Qs + (16 * w + 4 * g + r) * RS + (16 * nb + fr) * 2) = (bf16_t)f2bf(sd[r]); }
    float den[4];
#pragma unroll
    for (int r = 0; r < 4; ++r) { float d = dsum[r] + inter[r] * accn[r]; d += __shfl_xor(d, 1); d += __shfl_xor(d, 2); d += __shfl_xor(d, 4); d += __shfl_xor(d, 8); den[r] = d; }
    f32x4 acco[8];
#pragma unroll
    for (int vb = 0; vb < 8; ++vb) { acco[vb] = (f32x4){0.f, 0.f, 0.f, 0.f};
#pragma unroll
        for (int ks = 0; ks < 4; ++ks) { const bf16x8 bc = *(const LAS bf16x8*)(Cs + (16 * vb + fr) * RS + (32 * ks + 8 * g) * 2); acco[vb] = __builtin_amdgcn_mfma_f32_16x16x32_bf16(aq[ks], bc, acco[vb], 0, 0, 0); }
#pragma unroll
        for (int r = 0; r < 4; ++r) acco[vb][r] *= inter[r]; }
    __syncthreads();
#pragma unroll
    for (int ks = 0; ks < 4; ++ks) {
        if (2 * ks <= w) { const bf16x8 as_ = *(const LAS bf16x8*)(Qs + (16 * w + fr) * RS + (32 * ks + 8 * g) * 2);
#pragma unroll
            for (int vb = 0; vb < 8; ++vb) { const bf16x8 bv = tr2(Vs + (32 * ks + 8 * g + q) * RS + (16 * vb + 4 * pp) * 2); acco[vb] = __builtin_amdgcn_mfma_f32_16x16x32_bf16(as_, bv, acco[vb], 0, 0, 0); } } }
#pragma unroll
    for (int r = 0; r < 4; ++r) { const int tl = 16 * w + 4 * g + r; const float rinv = 1.f / fmaxf(fabsf(den[r]), __expf(negm[tl]));
        float ss = 0.f;
#pragma unroll
        for (int vb = 0; vb < 8; ++vb) { const float hv = acco[vb][r] * rinv; acco[vb][r] = hv; ss += hv * hv; }
        ss += __shfl_xor(ss, 1); ss += __shfl_xor(ss, 2); ss += __shfl_xor(ss, 4); ss += __shfl_xor(ss, 8);
        const float sc = rsqrtf(ss * (1.f / 128.f) + EPS);
        const bf16_t* pr = PROJ + (size_t)(rowbase + tl) * NPROJ + h * 128; bf16_t* yo = YC + (size_t)(b * 2048 + 128 * (c - 1) + tl) * 1024 + 512 + h * 128;
#pragma unroll
        for (int vb = 0; vb < 8; ++vb) { const int col = 16 * vb + fr; const float o = bf2f(pr[3584 + col]), z = bf2f(pr[4096 + col]);
            yo[col] = (bf16_t)f2bf(acco[vb][r] * sc * p.mh_gain[h * 128 + col] * sigmoidf_(o) * siluf_(z)); } }
    __syncthreads();
}

__global__ void __launch_bounds__(512, 2) fwd_megakernel(Params p) {
    extern __shared__ __attribute__((aligned(16))) unsigned char lds_raw[];
    LAS unsigned char* lds = (LAS unsigned char*)lds_raw;
    cg::grid_group grid = cg::this_grid();
    const int tid = threadIdx.x, lane = tid & 63, wave = __builtin_amdgcn_readfirstlane(tid >> 6);
    phase0(p, lds, tid, lane, wave);
    grid.sync();
    { pg8::Gemm g{(const pg8::bf16_t*)(p.ws + W_XN), (const pg8::bf16_t*)(p.ws + W_WTIN), MPAD, NPROJ, DM}; pg8::StaticOrder S; S.init(MPAD, NPROJ, (int)gridDim.x, (int)blockIdx.x);
      pg8::EpiBf16 E{(pg8::bf16_t*)(p.ws + W_PROJ), NPROJ};
      pg8::gemm_phase<pg8::EpiBf16, pg8::StaticOrder, false>((PG8_LAS unsigned char*)lds, g, S, E, nullptr);
      if (wave == 0) for (int bh = (int)gridDim.x - 1 - (int)blockIdx.x; bh < 32; bh += (int)gridDim.x) seq_scan(p, bh, lane); }
    grid.sync();
    for (int it = blockIdx.x; it < 544 + 81 + 512; it += gridDim.x) {
        if (it < 544) p2_chunk_local(p, lds, it, tid, lane, wave);
        else if (it < 625) { const int widx = (it - 544) * 8 + wave; if (widx < 648) p2_conv(p, widx, lane); }
        else p2_sample(p, lds, it - 625, tid, lane, wave);
    }
    grid.sync();
    phase3(p, tid);
    grid.sync();
    for (int it = blockIdx.x; it < 512; it += gridDim.x) p4_chunk_out(p, lds, it, tid, lane, wave);
    grid.sync();
    { pg8::Gemm g{(const pg8::bf16_t*)(p.ws + W_XN), (const pg8::bf16_t*)(p.ws + W_WTOUT), MOUT, DM, DM}; pg8::StaticOrder S; S.init(MOUT, DM, (int)gridDim.x, (int)blockIdx.x);
      pg8::EpiRes E{p.x_prompt, p.x_sample, p.out, (float*)(p.ws + W_ROWSS)};
      pg8::gemm_phase<pg8::EpiRes, pg8::StaticOrder, false>((PG8_LAS unsigned char*)lds, g, S, E, nullptr); }
    grid.sync();
    { const float* rowss = (const float*)(p.ws + W_ROWSS);
      for (int r = blockIdx.x * 8 + wave; r < MOUT; r += gridDim.x * 8) { const float sc = rsqrtf(rowss[r] * (1.f / 1024.f) + EPS); f32x4* o = (f32x4*)(p.out + (size_t)r * 1024);
#pragma unroll
          for (int j = 0; j < 4; ++j) { const f32x4 g = ((const f32x4*)p.fin_gain)[lane + 64 * j]; o[lane + 64 * j] = o[lane + 64 * j] * sc * g; } } }
}

extern "C" void kernel_launch(void* const* d_in, const int* in_sizes, int n_in, void* d_out, int out_size, void* d_ws, size_t ws_size, hipStream_t stream) {
    static int ready = 0;
    if (!ready) {
        if (n_in != 15 || ws_size < W_END) { fprintf(stderr, "kernel_launch: unexpected n_in %d or ws_size %zu (< %zu)\n", n_in, ws_size, (size_t)W_END); ready = -1; return; }
        if (hipFuncSetAttribute((const void*)fwd_megakernel, hipFuncAttributeMaxDynamicSharedMemorySize, LDS_BYTES) != hipSuccess) { fprintf(stderr, "kernel_launch: hipFuncSetAttribute failed\n"); ready = -1; return; }
        ready = 1;
    }
    if (ready < 0) return;
    Params p{};
    p.x_prompt = (const float*)d_in[0]; p.x_sample = (const float*)d_in[1]; p.st_conv = (const float*)d_in[2]; p.st_c = (const float*)d_in[3]; p.st_n = (const float*)d_in[4]; p.st_m = (const float*)d_in[5];
    p.meta = (const float*)d_in[6]; p.norm_gain = (const float*)d_in[7]; p.w_in = (const float*)d_in[8]; p.conv_w = (const float*)d_in[9]; p.b_ig = (const float*)d_in[10]; p.b_fg = (const float*)d_in[11];
    p.mh_gain = (const float*)d_in[12]; p.w_out = (const float*)d_in[13]; p.fin_gain = (const float*)d_in[14];
    p.out = (float*)d_out; p.ws = (unsigned char*)d_ws;
    void* args[] = {&p};
    const hipError_t e = hipLaunchCooperativeKernel((const void*)fwd_megakernel, dim3(256), dim3(512), args, LDS_BYTES, stream);
    if (e != hipSuccess) fprintf(stderr, "kernel_launch: cooperative launch failed: %s\n", hipGetErrorString(e));
}
```

```cpp
#include <hip/hip_runtime.h>
#include <hip/hip_cooperative_groups.h>
#include <cstdio>
namespace cg = cooperative_groups;
namespace pg8 {
#define PG8_LAS __attribute__((address_space(3)))
typedef unsigned short bf16_t;
typedef short bf16x8 __attribute__((ext_vector_type(8)));
typedef float f32x4 __attribute__((ext_vector_type(4)));
typedef unsigned u32x4 __attribute__((ext_vector_type(4)));
constexpr int BM = 256, BK = 64, HALF = 128, HTB = HALF * BK * 2  , STAGE_BYTES = 8 * HTB, NXCD = 8, WGM = 8;

__host__ __device__ __forceinline__ int lds_byte(int r, int c) { const int st = (r >> 4) * 2 + (c >> 5), rr = r & 15, cc = c & 31, ob = rr * 64 + cc * 2; return st * 1024 + (ob ^ (((ob >> 9) & 1) << 5)); }
__host__ __device__ __forceinline__ void stage_rc(int b, int& R, int& C) { const int st = b / 1024, sb = b % 1024, swz = sb ^ (((sb >> 9) & 1) << 5); R = (st >> 1) * 16 + swz / 64; C = (st & 1) * 32 + (swz % 64) / 2; }
__host__ __device__ __forceinline__ int perm32(int rho) { const int n = rho >> 4, i = rho & 15; return 8 * (i >> 2) + 4 * n + (i & 3); }

struct Unit { int pm, pn; };
struct Gemm { const bf16_t* A; const bf16_t* Bt; int M, N, K; };

struct StaticOrder {
    int nM, nN, nwg, G, c;
    __host__ __device__ void init(int M, int N, int G_, int c_) { nM = M / BM; nN = N / BM; nwg = nM * nN; G = G_; c = c_; }
    __host__ __device__ bool next(int i, Unit& u) const {
        const long L = (long)i * G + c; if (L >= nwg) return false;
        int wgid = (int)L; { const int q = nwg / NXCD, r = nwg % NXCD, xcd = wgid % NXCD, off = wgid / NXCD; wgid = (xcd < r ? xcd * (q + 1) : r * (q + 1) + (xcd - r) * q) + off; }
        const int nig = WGM * nN, gid = wgid / nig, fm = gid * WGM, gsz = (nM - fm) < WGM ? (nM - fm) : WGM;
        u.pm = fm + ((wgid % nig) % gsz); u.pn = (wgid % nig) / gsz; return true;
    }
    __device__ __forceinline__ void a_ready(const Unit&) const {}
    __device__ __forceinline__ void done(const Unit&) const {}
};
__device__ __forceinline__ unsigned cvt_pk_bf16(float lo, float hi) { unsigned r; asm volatile("v_cvt_pk_bf16_f32 %0, %1, %2" : "=v"(r) : "v"(lo), "v"(hi)); return r; }
struct EpiBf16 {
    static constexpr bool PERM = true, AFTER_DRAIN = false;
    bf16_t* O; int ldc;
    __device__ __forceinline__ void operator()(const f32x4 (&acc)[2][2][4][2], const Unit& u, int wr, int wc, int fr, int fq) const {
        const int row0 = u.pm * BM + wr * 64 + fr, col0 = u.pn * BM + wc * 32 + 8 * fq;
#pragma unroll
        for (int ai = 0; ai < 2; ++ai)
#pragma unroll
            for (int m = 0; m < 4; ++m) { bf16_t* rowp = O + (size_t)(row0 + ai * HALF + m * 16) * ldc + col0;
#pragma unroll
                for (int bj = 0; bj < 2; ++bj) { const f32x4 v0 = acc[ai][bj][m][0], v1 = acc[ai][bj][m][1];
                    u32x4 w; w.x = cvt_pk_bf16(v0[0], v0[1]); w.y = cvt_pk_bf16(v0[2], v0[3]); w.z = cvt_pk_bf16(v1[0], v1[1]); w.w = cvt_pk_bf16(v1[2], v1[3]);
                    *(u32x4*)(rowp + bj * HALF) = w; } }
    }
};
struct EpiRes {
    static constexpr bool PERM = false, AFTER_DRAIN = false;
    const float* xp; const float* xs; float* out; float* rowss;
    __device__ __forceinline__ void operator()(const f32x4 (&acc)[2][2][4][2], const Unit& u, int wr, int wc, int fr, int fq) const {
        const int row0 = u.pm * BM + wr * 64 + fr, col0 = u.pn * BM + wc * 32 + 4 * fq;
#pragma unroll
        for (int ai = 0; ai < 2; ++ai)
#pragma unroll
            for (int m = 0; m < 4; ++m) { const int r = row0 + ai * HALF + m * 16;
                const float* xrow = (r < 16384) ? xp + (size_t)r * 1024 : xs + (size_t)(r - 16384) * 1024; float* orow = out + (size_t)r * 1024; float ss = 0.f;
#pragma unroll
                for (int bj = 0; bj < 2; ++bj)
#pragma unroll
                    for (int n = 0; n < 2; ++n) { const int c = col0 + bj * HALF + n * 16; const f32x4 v = acc[ai][bj][m][n] + *(const f32x4*)(xrow + c); *(f32x4*)(orow + c) = v;
                        ss += (v[0] * v[0] + v[1] * v[1]) + (v[2] * v[2] + v[3] * v[3]); }
                ss += __shfl_xor(ss, 16); ss += __shfl_xor(ss, 32);
                if (fq == 0) __hip_atomic_fetch_add(rowss + r, ss, __ATOMIC_RELAXED, __HIP_MEMORY_SCOPE_AGENT);
                asm volatile("" ::: "memory"); }
    }
};

template <class Epi, class Sched, bool STAMP = false>
__device__ __forceinline__ void gemm_phase(PG8_LAS unsigned char* lds, const Gemm g, const Sched& S, const Epi& E, unsigned long long* stamps) {
    const int tid = threadIdx.x, wid = __builtin_amdgcn_readfirstlane(tid >> 6), lane = tid & 63, wr = wid >> 2, wc = wid & 3, fr = lane & 15, fq = lane >> 4;
    const int K = g.K, nt = K / BK;
    int ts_lo = 0, ts_hi = 0, nts = 0; const unsigned long long rt_entry = STAMP ? (unsigned long long)wall_clock64() : 0ull;
#define PG8_STAMP() do { if (STAMP && wid == 0 && nts < 64) { const unsigned long long _c = (unsigned long long)clock64(); \
        ts_lo = (lane == nts) ? (int)(unsigned)_c : ts_lo; ts_hi = (lane == nts) ? (int)(unsigned)(_c >> 32) : ts_hi; ++nts; } } while (0)
    PG8_STAMP();
    unsigned voffA[2], voffB[2];
#pragma unroll
    for (int i = 0; i < 2; ++i) { int R, C; stage_rc(tid * 16 + i * 8192, R, C); const int Rb = Epi::PERM ? ((R & ~31) + perm32(R & 31)) : R;
        voffA[i] = (unsigned)(R * K + C) * 2u; voffB[i] = (unsigned)(Rb * K + C) * 2u; }
    const size_t kstep = (size_t)(BK * 2);
    const size_t hstep = (size_t)HALF * K * 2;
    const size_t tstep = 2 * hstep;
    const unsigned ldsw = (unsigned)wid * 1024u;
    const int aoff = lds_byte(wr * 64 + fr, fq * 8), boff = lds_byte(wc * 32 + fr, fq * 8);
#define PG8_SA(b, h) (((b) * 2 + (h)) * HTB)
#define PG8_SB(b, h) ((4 + (b) * 2 + (h)) * HTB)
#define PG8_STAGE(bufoff, gbase, voff) do { _Pragma("unroll") for (int _i = 0; _i < 2; ++_i) \
        __builtin_amdgcn_global_load_lds((const unsigned*)((const char*)(gbase) + (voff)[_i]), (PG8_LAS unsigned*)(lds + (bufoff) + ldsw + _i * 8192), 16, 0, 0); } while (0)
#define PG8_LDA(dst, b, h) do { _Pragma("unroll") for (int m = 0; m < 4; ++m) _Pragma("unroll") for (int k = 0; k < 2; ++k) dst[m][k] = *(const PG8_LAS bf16x8*)(lds + PG8_SA(b, h) + aoff + m * 2048 + k * 1024); } while (0)
#define PG8_LDB(dst, b, h) do { _Pragma("unroll") for (int n = 0; n < 2; ++n) _Pragma("unroll") for (int k = 0; k < 2; ++k) dst[n][k] = *(const PG8_LAS bf16x8*)(lds + PG8_SB(b, h) + boff + n * 2048 + k * 1024); } while (0)
#define PG8_MMA(ai, bj, At, Bt) do { __builtin_amdgcn_s_setprio(1); _Pragma("unroll") for (int m = 0; m < 4; ++m) _Pragma("unroll") for (int n = 0; n < 2; ++n) _Pragma("unroll") for (int k = 0; k < 2; ++k) \
        acc[ai][bj][m][n] = __builtin_amdgcn_mfma_f32_16x16x32_bf16(Bt[n][k], At[m][k], acc[ai][bj][m][n], 0, 0, 0); __builtin_amdgcn_s_setprio(0); } while (0)
#define PG8_WAIT_V(n) asm volatile("s_waitcnt vmcnt(" #n ")" ::: "memory")
#define PG8_WAIT_L(n) asm volatile("s_waitcnt lgkmcnt(" #n ")" ::: "memory")
#define PG8_BAR __builtin_amdgcn_s_barrier()
#define PG8_SCHED __builtin_amdgcn_sched_barrier(0)
    Unit cur, nxt; int ui = 0;
    if (!S.next(0, cur)) return;
    f32x4 acc[2][2][4][2];
#pragma unroll
    for (int a = 0; a < 2; ++a)
#pragma unroll
        for (int b = 0; b < 2; ++b)
#pragma unroll
            for (int m = 0; m < 4; ++m)
#pragma unroll
                for (int n = 0; n < 2; ++n) acc[a][b][m][n] = (f32x4){0.f, 0.f, 0.f, 0.f};
    bf16x8 At[4][2], B0[2][2], B1[2][2];
    const char* cA = (const char*)g.A + (size_t)cur.pm * tstep; const char* cB = (const char*)g.Bt + (size_t)cur.pn * tstep;
    S.a_ready(cur);
    PG8_STAGE(PG8_SB(0, 0), cB, voffB); PG8_STAGE(PG8_SA(0, 0), cA, voffA); PG8_STAGE(PG8_SB(0, 1), cB + hstep, voffB); PG8_STAGE(PG8_SA(0, 1), cA + hstep, voffA);
    if (wr == 1) PG8_BAR;
    PG8_WAIT_V(4); PG8_BAR;
    PG8_STAGE(PG8_SB(1, 0), cB + kstep, voffB); PG8_STAGE(PG8_SA(1, 0), cA + kstep, voffA); PG8_STAGE(PG8_SB(1, 1), cB + hstep + kstep, voffB);
    PG8_WAIT_V(6); PG8_BAR;
    PG8_STAMP();
    for (;;) {
        const bool has_next = S.next(ui + 1, nxt);
        const char* nA = has_next ? (const char*)g.A + (size_t)nxt.pm * tstep : cA; const char* nB = has_next ? (const char*)g.Bt + (size_t)nxt.pn * tstep : cB;
        for (int t = 0; t < nt; t += 2) {
            const bool last = (t == nt - 2);
            const char* a1 = cA + (size_t)(t + 1) * kstep;
            const char* a2 = last ? nA : cA + (size_t)(t + 2) * kstep; const char* b2 = last ? nB : cB + (size_t)(t + 2) * kstep;
            const char* a3 = a2 + kstep; const char* b3 = b2 + kstep;
            if (last && has_next) S.a_ready(nxt);
            PG8_LDB(B0, 0, 0); PG8_SCHED; PG8_LDA(At, 0, 0); PG8_STAGE(PG8_SA(1, 1), a1 + hstep, voffA);
            PG8_WAIT_L(8); PG8_BAR; PG8_WAIT_L(0); PG8_MMA(0, 0, At, B0); PG8_BAR; PG8_SCHED;
            PG8_LDB(B1, 0, 1); PG8_STAGE(PG8_SB(0, 0), b2, voffB);
            PG8_BAR; PG8_WAIT_L(0); PG8_MMA(0, 1, At, B1); PG8_BAR;
            PG8_LDA(At, 0, 1); PG8_STAGE(PG8_SA(0, 0), a2, voffA);
            PG8_BAR; PG8_WAIT_L(0); PG8_MMA(1, 0, At, B0); PG8_BAR; PG8_SCHED;
            PG8_STAGE(PG8_SB(0, 1), b2 + hstep, voffB);
            PG8_WAIT_V(6); PG8_BAR; PG8_MMA(1, 1, At, B1); PG8_BAR;
            PG8_LDB(B0, 1, 0); PG8_SCHED; PG8_LDA(At, 1, 0); PG8_STAGE(PG8_SA(0, 1), a2 + hstep, voffA);
            PG8_WAIT_L(8); PG8_BAR; PG8_WAIT_L(0); PG8_MMA(0, 0, At, B0); PG8_BAR; PG8_SCHED;
            PG8_LDB(B1, 1, 1); PG8_STAGE(PG8_SB(1, 0), b3, voffB);
            PG8_BAR; PG8_WAIT_L(0); PG8_MMA(0, 1, At, B1); PG8_BAR;
            PG8_LDA(At, 1, 1); PG8_STAGE(PG8_SA(1, 0), a3, voffA);
            PG8_BAR; PG8_WAIT_L(0); PG8_MMA(1, 0, At, B0); PG8_BAR; PG8_SCHED;
            PG8_STAGE(PG8_SB(1, 1), b3 + hstep, voffB);
            PG8_WAIT_V(6); PG8_BAR; PG8_MMA(1, 1, At, B1); PG8_BAR;
        }
        PG8_STAMP();
        if constexpr (!Epi::AFTER_DRAIN) { E(acc, cur, wr, wc, fr, fq); S.done(cur); }
        PG8_STAMP();
        if (!has_next) break;
#pragma unroll
        for (int a = 0; a < 2; ++a)
#pragma unroll
            for (int b = 0; b < 2; ++b)
#pragma unroll
                for (int m = 0; m < 4; ++m)
#pragma unroll
                    for (int n = 0; n < 2; ++n) acc[a][b][m][n] = (f32x4){0.f, 0.f, 0.f, 0.f};
        cur = nxt; cA = nA; cB = nB; ++ui;
    }
    PG8_WAIT_V(0);
    if (wr == 0) PG8_BAR;
    PG8_BAR;
    if constexpr (Epi::AFTER_DRAIN) { E.fused(acc, cur, wr, wc, fr, fq, lds, wid, lane); S.done(cur); }
    PG8_STAMP();
    if (STAMP && wid == 0) { stamps[lane] = lane < nts ? (((unsigned long long)(unsigned)ts_hi << 32) | (unsigned)ts_lo) : 0ull;
        if (lane == 62) stamps[62] = rt_entry; if (lane == 63) stamps[63] = (unsigned long long)wall_clock64(); }
#undef PG8_STAMP
#undef PG8_SA
#undef PG8_SB
#undef PG8_STAGE
#undef PG8_LDA
#undef PG8_LDB
#undef PG8_MMA
#undef PG8_WAIT_V
#undef PG8_WAIT_L
#undef PG8_BAR
#undef PG8_SCHED
}
}

#define LAS __attribute__((address_space(3)))
typedef unsigned short bf16_t;
typedef short bf16x8 __attribute__((ext_vector_type(8)));
typedef short s16x4 __attribute__((ext_vector_type(4)));
typedef float f32x4 __attribute__((ext_vector_type(4)));
typedef unsigned u32x4 __attribute__((ext_vector_type(4)));
typedef unsigned u32x2 __attribute__((ext_vector_type(2)));

constexpr int DM = 1024, TP = 2064, NPROW = 8 * TP  , NROW = NPROW + 1024  , MPAD = 17664, NPROJ = 4608, LDW = 4616, MOUT = 17408;
constexpr int NCH = 17;
constexpr int RS = 272;
constexpr int TILE_B = 128 * RS;
constexpr int LDS_MISC = 147456;
constexpr int LDS_BYTES = 147456 + 64;
constexpr float KSCALE = 0.08838834764831845f;
constexpr float EPS = 1e-6f;
constexpr size_t O_YS = 16777216, O_CONVP = 17825792, O_CP = 17833984, O_NP = 18358272, O_MP = 18362368, O_CONVS = 18362400, O_CS = 18493472, O_NS = 26882080, O_MS = 26947616;
constexpr size_t W_WTIN = 0, W_WTOUT = 9437184, W_XN = 11534336, W_G = 47710208, W_A = 48271360, W_M = W_A + 264192, W_B = W_M + 264192, W_MLOC = 49063936, W_NLOC = 49068032,
                 W_NST = 49346560, W_ROWSS = 49625088, W_PROJ = 49694720, W_LLOC = 212486144, W_CST = 248137728, W_BAR = 265963520, W_END = W_BAR + 16384;

struct Params {
    const float *x_prompt, *x_sample, *st_conv, *st_c, *st_n, *st_m, *meta, *norm_gain, *w_in, *conv_w, *b_ig, *b_fg, *mh_gain, *w_out, *fin_gain;
    float* out; unsigned char* ws;
};

__device__ __forceinline__ float wave_sum(float v) {
#pragma unroll
    for (int o = 1; o < 64; o <<= 1) v += __shfl_xor(v, o);
    return v;
}
__device__ __forceinline__ float wave_max(float v) {
#pragma unroll
    for (int o = 1; o < 64; o <<= 1) v = fmaxf(v, __shfl_xor(v, o));
    return v;
}
__device__ __forceinline__ unsigned f2bf(float f) { unsigned u = __float_as_uint(f); return (u + 0x7fffu + ((u >> 16) & 1u)) >> 16; }
__device__ __forceinline__ unsigned pk2(float lo, float hi) { return f2bf(lo) | (f2bf(hi) << 16); }
__device__ __forceinline__ float bf2f(unsigned b) { return __uint_as_float(b << 16); }
__device__ __forceinline__ float bflo(unsigned w) { return __uint_as_float(w << 16); }
__device__ __forceinline__ float bfhi(unsigned w) { return __uint_as_float(w & 0xffff0000u); }
__device__ __forceinline__ float sigmoidf_(float x) { return 1.f / (1.f + __expf(-x)); }
__device__ __forceinline__ float siluf_(float x) { return x / (1.f + __expf(-x)); }
__device__ __forceinline__ bf16x8 tr2(LAS unsigned char* p0) {
    const s16x4 lo = __builtin_amdgcn_ds_read_tr16_b64_v4i16((LAS s16x4*)p0);
    const s16x4 hi = __builtin_amdgcn_ds_read_tr16_b64_v4i16((LAS s16x4*)(p0 + 4 * RS));
    return __builtin_shufflevector(lo, hi, 0, 1, 2, 3, 4, 5, 6, 7);
}

#define XB_TMO      128
#define XB_XCNT(j)  (256  + 64 * (j))
#define XB_XSUB(j)  (1280 + 64 * (j))
#define XB_XGEN(j)  (2304 + 64 * (j))
#define XB_TOP      3328
#define XB_TOPGEN   3392
#define XCD_BAR_WORDS 3456
#define XB_SPIN_CAP (1u << 18)

__device__ __forceinline__ unsigned xb_ld(unsigned* p)              { return __hip_atomic_load(p, __ATOMIC_RELAXED, __HIP_MEMORY_SCOPE_AGENT); }
__device__ __forceinline__ unsigned xb_add(unsigned* p, unsigned v) { return __hip_atomic_fetch_add(p, v, __ATOMIC_RELAXED, __HIP_MEMORY_SCOPE_AGENT); }
__device__ __forceinline__ unsigned xb_xcc_id() { return (unsigned)__builtin_amdgcn_s_getreg((3 << 11) | 20) & 0xFu; }
#define XB_SPIN(cond, bar) do { unsigned _sp = 0; while (cond) { __builtin_amdgcn_s_sleep(1); \
    if ((++_sp & 255u) == 0u) { if (xb_ld(&(bar)[XB_TMO])) break; if (_sp > XB_SPIN_CAP) { atomicAdd(&(bar)[XB_TMO], 1u); break; } } } } while (0)

struct XcdBarrier {
    unsigned* bar; unsigned x;
    volatile LAS unsigned* st;
};

__device__ __forceinline__ XcdBarrier xcd_barrier_post(unsigned* bar, volatile LAS unsigned* st) {
    XcdBarrier b; b.bar = bar; b.x = xb_xcc_id(); b.st = st;
    if (threadIdx.x == 0) (void)xb_add(&bar[XB_XCNT(b.x)], 1u);
    return b;
}
__device__ __forceinline__ void xcd_barrier_complete(unsigned* bar, unsigned x, unsigned& nloc, unsigned& nx) {
    const unsigned G = gridDim.x * gridDim.y * gridDim.z;
    unsigned sum, cnt, mine, sp = 0u;
    for (;;) {
        sum = 0u; cnt = 0u; mine = 0u;
#pragma unroll
        for (unsigned j = 0; j < 16; ++j) { const unsigned c = xb_ld(&bar[XB_XCNT(j)]); sum += c; cnt += (c > 0u) ? 1u : 0u; mine = (j == x) ? c : mine; }
        if (sum == G) break;
        __builtin_amdgcn_s_sleep(1);
        if ((++sp & 255u) == 0u) { if (xb_ld(&bar[XB_TMO])) break; if (sp > XB_SPIN_CAP) { atomicAdd(&bar[XB_TMO], 1u); break; } }
    }
    nloc = mine > 0u ? mine : 1u; nx = cnt > 0u ? cnt : 1u;
}

__device__ __forceinline__ void xcd_barrier(const XcdBarrier& b) {
    asm volatile("s_waitcnt vmcnt(0)" ::: "memory");
    __syncthreads();
    if (threadIdx.x == 0) {
        unsigned* bar = b.bar;
        __builtin_amdgcn_s_waitcnt(0);
        unsigned nloc = b.st[0], nx = b.st[1];
        if (nloc == 0u) { xcd_barrier_complete(bar, b.x, nloc, nx); b.st[0] = nloc; b.st[1] = nx; }
        const unsigned old = xb_add(&bar[XB_XSUB(b.x)], 1u);
        const unsigned gen = old / nloc;
        if (old + 1u == (gen + 1u) * nloc) {
            __builtin_amdgcn_fence(__ATOMIC_RELEASE, "agent");
            asm volatile("s_waitcnt vmcnt(0)" ::: "memory");
            const unsigned og = xb_add(&bar[XB_TOP], 1u);
            const unsigned tg = og / nx;
            if (og + 1u == (tg + 1u) * nx) xb_add(&bar[XB_TOPGEN], 1u);
            else XB_SPIN(xb_ld(&bar[XB_TOPGEN]) == tg, bar);
            __builtin_amdgcn_fence(__ATOMIC_ACQUIRE, "agent");
            xb_add(&bar[XB_XGEN(b.x)], 1u);
            asm volatile("s_waitcnt vmcnt(0)" ::: "memory");
        } else {
            XB_SPIN(xb_ld(&bar[XB_XGEN(b.x)]) == gen, bar);
            __builtin_amdgcn_fence(__ATOMIC_ACQUIRE, "agent");
            asm volatile("s_waitcnt vmcnt(0)" ::: "memory");
        }
    }
    __syncthreads();
}

__device__ __forceinline__ void p0_transpose_item(const float* W, int ldw, int nblk, bf16_t* WT, int K, LAS float* scr, int item, int lane) {
    const int kb = item / nblk, nb = item % nblk, k0 = 64 * kb, n0 = 32 * nb;
#pragma unroll 8
    for (int i = 0; i < 32; ++i) { const int kk = 2 * i + (lane >> 5); scr[kk * 33 + (lane & 31)] = W[(size_t)(k0 + kk) * ldw + n0 + (lane & 31)]; }
    asm volatile("s_waitcnt lgkmcnt(0)" ::: "memory");
    const int c = lane & 7;
#pragma unroll
    for (int j = 0; j < 4; ++j) { const int n = (lane >> 3) + 8 * j; const LAS float* s = scr + (8 * c) * 33 + n;
        u32x4 o; o.x = pk2(s[0 * 33], s[1 * 33]); o.y = pk2(s[2 * 33], s[3 * 33]); o.z = pk2(s[4 * 33], s[5 * 33]); o.w = pk2(s[6 * 33], s[7 * 33]);
        *(u32x4*)(WT + (size_t)(n0 + n) * K + k0 + 8 * c) = o; }
    asm volatile("s_waitcnt lgkmcnt(0)" ::: "memory");
}

__device__ __forceinline__ void phase0(const Params& p, LAS unsigned char* lds, int tid, int lane, int wave) {
    LAS float* gwl = (LAS float*)lds;
    LAS float* scr = (LAS float*)(lds + 32768) + wave * (64 * 33);
    for (int i = tid; i < 8192; i += 512) { const int k = i >> 3, j = i & 7; gwl[j * 1024 + k] = p.w_in[(size_t)k * LDW + NPROJ + j]; }
    __syncthreads();
    const int gw = blockIdx.x * 8 + wave, NGW = gridDim.x * 8;
    float* rowss = (float*)(p.ws + W_ROWSS);
    for (int i = blockIdx.x * 512 + tid; i < MOUT; i += gridDim.x * 512) rowss[i] = 0.f;
    bf16_t* XN = (bf16_t*)(p.ws + W_XN);
    for (int i = blockIdx.x * 512 + tid; i < 16384; i += gridDim.x * 512) ((u32x4*)(XN + (size_t)NROW * 1024))[i] = (u32x4){0u, 0u, 0u, 0u};
    for (int it = gw; it < 2304 + 512; it += NGW) {
        if (it < 2304) p0_transpose_item(p.w_in, LDW, 144, (bf16_t*)(p.ws + W_WTIN), 1024, scr, it, lane);
        else p0_transpose_item(p.w_out, 1024, 32, (bf16_t*)(p.ws + W_WTOUT), 1024, scr, it - 2304, lane);
    }
    float* G = (float*)(p.ws + W_G);
    for (int r = gw; r < NROW; r += NGW) {
        const float* src;
        if (r < NPROW) { const int b = r / TP, t = r - b * TP; src = (t < 16) ? p.meta + t * 1024 : p.x_prompt + ((size_t)b * 2048 + (t - 16)) * 1024; }
        else src = p.x_sample + (size_t)(r - NPROW) * 1024;
        f32x4 v[4]; float ss = 0.f;
#pragma unroll
        for (int j = 0; j < 4; ++j) { v[j] = ((const f32x4*)src)[lane + 64 * j]; ss += (v[j][0] * v[j][0] + v[j][1] * v[j][1]) + (v[j][2] * v[j][2] + v[j][3] * v[j][3]); }
        const float rstd = rsqrtf(wave_sum(ss) * (1.f / 1024.f) + EPS);
#pragma unroll
        for (int j = 0; j < 4; ++j) { const f32x4 g = ((const f32x4*)p.norm_gain)[lane + 64 * j]; v[j] = v[j] * rstd * g;
            u32x2 o; o.x = pk2(v[j][0], v[j][1]); o.y = pk2(v[j][2], v[j][3]); ((u32x2*)(XN + (size_t)r * 1024))[lane + 64 * j] = o; }
        float ga[8];
#pragma unroll
        for (int q = 0; q < 8; ++q) { float s = 0.f;
#pragma unroll
            for (int j = 0; j < 4; ++j) { const f32x4 w = *(const LAS f32x4*)(gwl + q * 1024 + 4 * (lane + 64 * j)); s += (v[j][0] * w[0] + v[j][1] * w[1]) + (v[j][2] * w[2] + v[j][3] * w[3]); }
            ga[q] = wave_sum(s); }
        if (lane == 0) {
#pragma unroll
            for (int h = 0; h < 4; ++h) { G[(size_t)r * 8 + h] = ga[h] + p.b_ig[h]; const float x = ga[4 + h] + p.b_fg[h]; G[(size_t)r * 8 + 4 + h] = fminf(x, 0.f) - log1pf(expf(-fabsf(x))); }
        }
    }
}

__device__ __forceinline__ void seq_scan(const Params& p, int bh, int lane) {
    const float* G = (const float*)(p.ws + W_G); float* A = (float*)(p.ws + W_A) + bh * TP; float* M = (float*)(p.ws + W_M) + bh * TP; float* Bc = (float*)(p.ws + W_B) + bh * TP;
    const int b = bh >> 2, h = bh & 3; float cB = 0.f, cM = 0.f;
    for (int it = 0; it < 33; ++it) { const int t = it * 64 + lane; const bool valid = t < TP; const size_t row = (size_t)b * TP + (valid ? t : 0);
        const float lf = valid ? G[row * 8 + 4 + h] : 0.f, ig = valid ? G[row * 8 + h] : -INFINITY;
        float s = lf;
#pragma unroll
        for (int o = 1; o < 64; o <<= 1) { const float n = __shfl_up(s, o); if (lane >= o) s += n; }
        const float Bt = cB + s; const float a = valid ? ig - Bt : -INFINITY; float m = a;
#pragma unroll
        for (int o = 1; o < 64; o <<= 1) { const float n = __shfl_up(m, o); if (lane >= o) m = fmaxf(m, n); }
        const float Mt = fmaxf(cM, m);
        if (valid) { A[t] = a; M[t] = Mt; Bc[t] = Bt; }
        cB = __shfl(Bt, 63); cM = __shfl(Mt, 63); }
}

__device__ __forceinline__ void p2_chunk_local(const Params& p, LAS unsigned char* lds, int it, int tid, int lane, int wave) {
    LAS unsigned char* Ks = lds; LAS unsigned char* Vs = lds + TILE_B; LAS float* wl = (LAS float*)(lds + 2 * TILE_B);
    const int bh = it / NCH, c = it - bh * NCH, b = bh >> 2, h = bh & 3, t0 = c ? 16 + 128 * (c - 1) : 0, L = c ? 128 : 16;
    const float* Aseq = (const float*)(p.ws + W_A) + bh * TP + t0;
    const float a0 = lane < L ? Aseq[lane] : -INFINITY, a1 = lane + 64 < L ? Aseq[lane + 64] : -INFINITY;
    const float Mloc = wave_max(fmaxf(a0, a1));
    if (wave == 0) { wl[lane] = lane < L ? __expf(a0 - Mloc) : 0.f; wl[lane + 64] = lane + 64 < L ? __expf(a1 - Mloc) : 0.f; }
    const bf16_t* PROJ = (const bf16_t*)(p.ws + W_PROJ);
#pragma unroll
    for (int i = 0; i < 4; ++i) { const int idx = tid + 512 * i, s = idx >> 4, ch = idx & 15;
        const bf16_t* pr = PROJ + (size_t)(b * TP + t0 + s) * NPROJ + h * 128 + ch * 8;
        const u32x4 kv = *(const u32x4*)(pr + 2560); u32x4 vv = *(const u32x4*)(pr + 3072);
        const float w = s < L ? __expf(Aseq[s] - Mloc) : 0.f;
        vv.x = pk2(bflo(vv.x) * w, bfhi(vv.x) * w); vv.y = pk2(bflo(vv.y) * w, bfhi(vv.y) * w); vv.z = pk2(bflo(vv.z) * w, bfhi(vv.z) * w); vv.w = pk2(bflo(vv.w) * w, bfhi(vv.w) * w);
        *(LAS u32x4*)(Ks + s * RS + ch * 16) = kv; *(LAS u32x4*)(Vs + s * RS + ch * 16) = vv; }
    __syncthreads();
    const int fr = lane & 15, g = lane >> 4, q = fr >> 2, pp = fr & 3;
    bf16x8 af[4];
#pragma unroll
    for (int ks = 0; ks < 4; ++ks) af[ks] = tr2(Vs + (32 * ks + 8 * g + q) * RS + (16 * wave + 4 * pp) * 2);
    float* LT = (float*)(p.ws + W_LLOC) + (size_t)it * 16384;
#pragma unroll
    for (int nb = 0; nb < 8; ++nb) { f32x4 acc = {0.f, 0.f, 0.f, 0.f};
#pragma unroll
        for (int ks = 0; ks < 4; ++ks) { const bf16x8 bk = tr2(Ks + (32 * ks + 8 * g + q) * RS + (16 * nb + 4 * pp) * 2); acc = __builtin_amdgcn_mfma_f32_16x16x32_bf16(af[ks], bk, acc, 0, 0, 0); }
#pragma unroll
        for (int r = 0; r < 4; ++r) LT[(16 * wave + 4 * g + r) * 128 + 16 * nb + fr] = acc[r] * KSCALE; }
    if (tid < 128) { float s = 0.f;
        for (int ss = 0; ss < 128; ++ss) s += wl[ss] * bf2f(*(const LAS bf16_t*)(Ks + ss * RS + tid * 2));
        ((float*)(p.ws + W_NLOC))[(size_t)it * 128 + tid] = s * KSCALE; }
    if (tid == 0) ((float*)(p.ws + W_MLOC))[it] = Mloc;
    __syncthreads();
}

__device__ __forceinline__ void ld8(const bf16_t* src, float (&o)[8]) { const u32x4 r = *(const u32x4*)src; o[0] = bflo(r.x); o[1] = bfhi(r.x); o[2] = bflo(r.y); o[3] = bfhi(r.y); o[4] = bflo(r.z); o[5] = bfhi(r.z); o[6] = bflo(r.w); o[7] = bfhi(r.w); }
__device__ __forceinline__ void ld8f(const float* src, float (&o)[8]) { const f32x4 a = *(const f32x4*)src, b = *(const f32x4*)(src + 4); o[0] = a[0]; o[1] = a[1]; o[2] = a[2]; o[3] = a[3]; o[4] = b[0]; o[5] = b[1]; o[6] = b[2]; o[7] = b[3]; }
__device__ __forceinline__ void st8f(float* dst, const float (&o)[8]) { *(f32x4*)dst = (f32x4){o[0], o[1], o[2], o[3]}; *(f32x4*)(dst + 4) = (f32x4){o[4], o[5], o[6], o[7]}; }
__device__ __forceinline__ void p2_conv(const Params& p, int widx, int lane) {
    const bf16_t* PROJ = (const bf16_t*)(p.ws + W_PROJ); bf16_t* YC = (bf16_t*)(p.ws + W_XN);
    const int c0 = lane * 8; const bool sample = widx >= 520;
    int rowbase, t0, len, sb = 0, b = 0;
    if (!sample) { b = widx / 65; const int seg = widx - b * 65; t0 = 32 * seg; len = (TP - t0) < 32 ? (TP - t0) : 32; rowbase = b * TP; }
    else { sb = widx - 520; t0 = 0; len = 8; rowbase = NPROW + sb * 8; }
    float w0[8], w1[8], w2[8], u1[8], u2[8];
    ld8f(p.conv_w + c0, w0); ld8f(p.conv_w + 512 + c0, w1); ld8f(p.conv_w + 1024 + c0, w2);
    if (sample) { ld8f(p.st_conv + (size_t)sb * 1024 + c0, u2); ld8f(p.st_conv + (size_t)sb * 1024 + 512 + c0, u1); }
    else if (t0 == 0) {
#pragma unroll
        for (int i = 0; i < 8; ++i) { u1[i] = 0.f; u2[i] = 0.f; } }
    else { float gc[8], hc[8];
        const bf16_t* pr = PROJ + (size_t)(rowbase + t0 - 2) * NPROJ + c0; ld8(pr + 512, gc); ld8(pr + 1024, hc);
#pragma unroll
        for (int i = 0; i < 8; ++i) u2[i] = gc[i] * hc[i];
        pr += NPROJ; ld8(pr + 512, gc); ld8(pr + 1024, hc);
#pragma unroll
        for (int i = 0; i < 8; ++i) u1[i] = gc[i] * hc[i]; }
    for (int tt = 0; tt < len; ++tt) { const int t = t0 + tt; const bf16_t* pr = PROJ + (size_t)(rowbase + t) * NPROJ + c0;
        float gb[8], gc[8], hc[8], zc[8], u[8]; ld8(pr, gb); ld8(pr + 512, gc); ld8(pr + 1024, hc); ld8(pr + 1536, zc);
        u32x4 o; float y[8];
#pragma unroll
        for (int i = 0; i < 8; ++i) { u[i] = gc[i] * hc[i]; const float yc = w0[i] * u2[i] + w1[i] * u1[i] + w2[i] * u[i]; y[i] = gb[i] * yc * siluf_(zc[i]); }
        o.x = pk2(y[0], y[1]); o.y = pk2(y[2], y[3]); o.z = pk2(y[4], y[5]); o.w = pk2(y[6], y[7]);
        if (sample) { *(u32x4*)(YC + (size_t)(16384 + sb * 8 + t) * 1024 + c0) = o; if (t >= 6) st8f(p.out + O_CONVS + (size_t)sb * 1024 + (t - 6) * 512 + c0, u); }
        else { if (t >= 16) *(u32x4*)(YC + (size_t)(b * 2048 + t - 16) * 1024 + c0) = o; if (t >= TP - 2) st8f(p.out + O_CONVP + (size_t)b * 1024 + (t - (TP - 2)) * 512 + c0, u); }
#pragma unroll
        for (int i = 0; i < 8; ++i) { u2[i] = u1[i]; u1[i] = u[i]; } }
}

__device__ __forceinline__ void p2_sample(const Params& p, LAS unsigned char* lds, int si, int tid, int lane, int wave) {
    LAS float* ql = (LAS float*)lds; LAS float* kl = ql + 1024; LAS float* vl = kl + 1024; LAS float* sdl = vl + 1024; LAS float* qnl = sdl + 64; LAS float* red = qnl + 64;
    const int sb = si >> 2, h = si & 3, rowbase = NPROW + sb * 8; const size_t sh = (size_t)sb * 4 + h;
    const float* G = (const float*)(p.ws + W_G); const bf16_t* PROJ = (const bf16_t*)(p.ws + W_PROJ); bf16_t* YC = (bf16_t*)(p.ws + W_XN);
    const float mprev = p.st_m[sh];
    float a[8], M[8], bc[8];
    { float run = 0.f, Mr = mprev;
#pragma unroll
      for (int t = 0; t < 8; ++t) { run += G[(size_t)(rowbase + t) * 8 + 4 + h]; bc[t] = run; a[t] = G[(size_t)(rowbase + t) * 8 + h] - run; Mr = fmaxf(Mr, a[t]); M[t] = Mr; } }
    float Mt = M[0], bt = bc[0];
#pragma unroll
    for (int t = 1; t < 8; ++t) { Mt = (wave == t) ? M[t] : Mt; bt = (wave == t) ? bc[t] : bt; }
    if (tid < 384) { const int mat = tid >> 7, rem = tid & 127, t = rem >> 4, ch = rem & 15; float x[8];
        ld8(PROJ + (size_t)(rowbase + t) * NPROJ + 2048 + mat * 512 + h * 128 + ch * 8, x);
        const float sc = (mat == 1) ? KSCALE : 1.f; LAS float* dst = ql + mat * 1024 + t * 128 + ch * 8;
        *(LAS f32x4*)dst = (f32x4){x[0] * sc, x[1] * sc, x[2] * sc, x[3] * sc}; *(LAS f32x4*)(dst + 4) = (f32x4){x[4] * sc, x[5] * sc, x[6] * sc, x[7] * sc}; }
    __syncthreads();
    const float* nprev = p.st_n + sh * 128;
    { const int t = wave; const float q0 = ql[t * 128 + lane], q1 = ql[t * 128 + lane + 64];
      const float qn = wave_sum(q0 * nprev[lane] + q1 * nprev[lane + 64]);
#pragma unroll
      for (int s = 0; s < 8; ++s) { const float d = wave_sum(q0 * kl[s * 128 + lane] + q1 * kl[s * 128 + lane + 64]); const float val = (s <= t) ? d * __expf(a[s] - Mt) : 0.f; if (lane == 0) sdl[t * 8 + s] = val; }
      if (lane == 0) qnl[t] = qn; }
    __syncthreads();
    const float decay = __expf(mprev - M[7]);
    float wS[8];
#pragma unroll
    for (int s = 0; s < 8; ++s) wS[s] = __expf(a[s] - M[7]);
    { const int dg = tid >> 5, v4 = tid & 31; const size_t coff = (sh * 128 + dg * 8) * 128 + v4 * 4;
      const float* Cp = p.st_c + coff; float* Cn = p.out + O_CS + coff;
      f32x4 Cv[8];
#pragma unroll
      for (int i = 0; i < 8; ++i) Cv[i] = *(const f32x4*)(Cp + i * 128);
#pragma unroll
      for (int t = 0; t < 8; ++t) { f32x4 pt = {0.f, 0.f, 0.f, 0.f};
#pragma unroll
          for (int i = 0; i < 8; ++i) pt += ql[t * 128 + dg * 8 + i] * Cv[i];
          *(LAS f32x4*)(red + (dg * 8 + t) * 128 + v4 * 4) = pt; }
#pragma unroll
      for (int i = 0; i < 8; ++i) { f32x4 cn = decay * Cv[i];
#pragma unroll
          for (int s = 0; s < 8; ++s) cn += (wS[s] * kl[s * 128 + dg * 8 + i]) * *(const LAS f32x4*)(vl + s * 128 + v4 * 4);
          *(f32x4*)(Cn + i * 128) = cn; } }
    __syncthreads();
    { const int t = wave; const float inter = __expf(mprev - Mt), mt = bt + Mt;
      float n0 = 0.f, n1 = 0.f;
#pragma unroll
      for (int dg = 0; dg < 16; ++dg) { n0 += red[(dg * 8 + t) * 128 + lane]; n1 += red[(dg * 8 + t) * 128 + lane + 64]; }
      n0 *= inter; n1 *= inter; float den = inter * qnl[t];
#pragma unroll
      for (int s = 0; s < 8; ++s) { const float sd = sdl[t * 8 + s]; n0 += sd * vl[s * 128 + lane]; n1 += sd * vl[s * 128 + lane + 64]; den += sd; }
      const float dd = fmaxf(fabsf(den), __expf(-mt)); const float h0 = n0 / dd, h1 = n1 / dd;
      const float sc = rsqrtf(wave_sum(h0 * h0 + h1 * h1) * (1.f / 128.f) + EPS);
      const bf16_t* pr = PROJ + (size_t)(rowbase + t) * NPROJ + h * 128;
      const float o0 = bf2f(pr[3584 + lane]), o1 = bf2f(pr[3584 + lane + 64]), z0 = bf2f(pr[4096 + lane]), z1 = bf2f(pr[4096 + lane + 64]);
      const float y0 = h0 * sc * p.mh_gain[h * 128 + lane] * sigmoidf_(o0) * siluf_(z0), y1 = h1 * sc * p.mh_gain[h * 128 + lane + 64] * sigmoidf_(o1) * siluf_(z1);
      bf16_t* yo = YC + (size_t)(16384 + sb * 8 + t) * 1024 + 512 + h * 128; yo[lane] = (bf16_t)f2bf(y0); yo[lane + 64] = (bf16_t)f2bf(y1); }
    if (tid < 128) { float nn = decay * nprev[tid];
#pragma unroll
        for (int s = 0; s < 8; ++s) nn += wS[s] * kl[s * 128 + tid];
        p.out[O_NS + sh * 128 + tid] = nn; }
    if (tid == 0) p.out[O_MS + sh] = bc[7] + M[7];
    __syncthreads();
}

__device__ __forceinline__ void phase3(const Params& p, int tid) {
    const float* Mall = (const float*)(p.ws + W_M); const float* MLOC = (const float*)(p.ws + W_MLOC);
    const float* LLOC = (const float*)(p.ws + W_LLOC); bf16_t* CST = (bf16_t*)(p.ws + W_CST);
    for (int e = blockIdx.x * 512 + tid; e < 32 * 4096; e += gridDim.x * 512) {
        const int bh = e >> 12, rem = e & 4095, v = rem >> 5, d4 = rem & 31; const float* Mseq = Mall + bh * TP;
        f32x4 st = {0.f, 0.f, 0.f, 0.f}; float Eprev = 0.f;
#pragma unroll
        for (int c = 0; c < NCH; ++c) { const size_t off = (size_t)(bh * NCH + c) * 16384 + v * 128 + d4 * 4;
            u32x2 o; o.x = pk2(st[0], st[1]); o.y = pk2(st[2], st[3]); *(u32x2*)(CST + off) = o;
            const float Ec = Mseq[c ? 16 + 128 * c - 1 : 15], Ml = MLOC[bh * NCH + c]; const f32x4 Lv = *(const f32x4*)(LLOC + off);
            st = __expf(Eprev - Ec) * st + __expf(Ml - Ec) * Lv; Eprev = Ec; }
#pragma unroll
        for (int j = 0; j < 4; ++j) p.out[O_CP + ((size_t)bh * 128 + d4 * 4 + j) * 128 + v] = st[j];
    }
    const float* NLOC = (const float*)(p.ws + W_NLOC); float* NST = (float*)(p.ws + W_NST);
    for (int e = blockIdx.x * 512 + tid; e < 32 * 128; e += gridDim.x * 512) {
        const int bh = e >> 7, d = e & 127; const float* Mseq = Mall + bh * TP; float st = 0.f, Eprev = 0.f;
        for (int c = 0; c < NCH; ++c) { const size_t off = (size_t)(bh * NCH + c) * 128 + d; NST[off] = st;
            const float Ec = Mseq[c ? 16 + 128 * c - 1 : 15], Ml = MLOC[bh * NCH + c];
            st = __expf(Eprev - Ec) * st + __expf(Ml - Ec) * NLOC[off]; Eprev = Ec; }
        p.out[O_NP + e] = st;
        if (d == 0) p.out[O_MP + bh] = ((const float*)(p.ws + W_B))[bh * TP + TP - 1] + Mseq[TP - 1];
    }
}

__device__ __forceinline__ void p4_chunk_out(const Params& p, LAS unsigned char* lds, int it, int tid, int lane, int wave) {
    LAS unsigned char* Qs = lds; LAS unsigned char* Ks = lds + TILE_B; LAS unsigned char* Vs = lds + 2 * TILE_B; LAS unsigned char* Cs = lds + 3 * TILE_B;
    LAS float* al = (LAS float*)(lds + 4 * TILE_B); LAS float* Ml = al + 128; LAS float* negm = Ml + 128; LAS float* nsl = negm + 128;
    const int bh = it >> 4, c = (it & 15) + 1, b = bh >> 2, h = bh & 3, t0 = 16 + 128 * (c - 1), rowbase = b * TP + t0;
    const bf16_t* PROJ = (const bf16_t*)(p.ws + W_PROJ); bf16_t* YC = (bf16_t*)(p.ws + W_XN);
    const bf16_t* CT = (const bf16_t*)(p.ws + W_CST) + (size_t)(bh * NCH + c) * 16384;
    const float* Mseq = (const float*)(p.ws + W_M) + bh * TP;
#pragma unroll
    for (int i = 0; i < 4; ++i) { const int idx = tid + 512 * i, s = idx >> 4, ch = idx & 15;
        const bf16_t* pr = PROJ + (size_t)(rowbase + s) * NPROJ + h * 128 + ch * 8;
        *(LAS u32x4*)(Qs + s * RS + ch * 16) = *(const u32x4*)(pr + 2048); *(LAS u32x4*)(Ks + s * RS + ch * 16) = *(const u32x4*)(pr + 2560);
        *(LAS u32x4*)(Vs + s * RS + ch * 16) = *(const u32x4*)(pr + 3072); *(LAS u32x4*)(Cs + s * RS + ch * 16) = *(const u32x4*)(CT + s * 128 + ch * 8); }
    if (tid < 128) { const float m = Mseq[t0 + tid]; al[tid] = ((const float*)(p.ws + W_A))[bh * TP + t0 + tid]; Ml[tid] = m; negm[tid] = -(((const float*)(p.ws + W_B))[bh * TP + t0 + tid] + m);
        nsl[tid] = ((const float*)(p.ws + W_NST))[(size_t)(bh * NCH + c) * 128 + tid]; }
    const float Eprev = Mseq[t0 - 1];
    __syncthreads();
    const int fr = lane & 15, g = lane >> 4, q = fr >> 2, pp = fr & 3, w = wave;
    bf16x8 aq[4];
#pragma unroll
    for (int ks = 0; ks < 4; ++ks) aq[ks] = *(const LAS bf16x8*)(Qs + (16 * w + fr) * RS + (32 * ks + 8 * g) * 2);
    f32x4 accn = {0.f, 0.f, 0.f, 0.f};
#pragma unroll
    for (int ks = 0; ks < 4; ++ks) { bf16x8 bn;
#pragma unroll
        for (int j = 0; j < 8; ++j) bn[j] = (fr == 0) ? (short)f2bf(nsl[32 * ks + 8 * g + j]) : (short)0;
        accn = __builtin_amdgcn_mfma_f32_16x16x32_bf16(aq[ks], bn, accn, 0, 0, 0); }
    float Mt[4], inter[4], dsum[4];
#pragma unroll
    for (int r = 0; r < 4; ++r) { Mt[r] = Ml[16 * w + 4 * g + r]; inter[r] = __expf(Eprev - Mt[r]); dsum[r] = 0.f; }
#pragma unroll
    for (int nb = 0; nb < 8; ++nb) { float sd[4] = {0.f, 0.f, 0.f, 0.f};
        if (nb <= w) { f32x4 s = {0.f, 0.f, 0.f, 0.f};
#pragma unroll
            for (int ks = 0; ks < 4; ++ks) { const bf16x8 bk = *(const LAS bf16x8*)(Ks + (16 * nb + fr) * RS + (32 * ks + 8 * g) * 2); s = __builtin_amdgcn_mfma_f32_16x16x32_bf16(aq[ks], bk, s, 0, 0, 0); }
            const float as = al[16 * nb + fr]; const int scol = 16 * nb + fr;
#pragma unroll
            for (int r = 0; r < 4; ++r) { const int trow = 16 * w + 4 * g + r; const float val = (scol <= trow) ? s[r] * KSCALE * __expf(as - Mt[r]) : 0.f; dsum[r] += val; sd[r] = val; } }
#pragma unroll
        for (int r = 0; r < 4; ++r) *(LAS bf16_t*)(Qs + (16 * w + 4 * g + r) * RS + (16 * nb + fr) * 2) = (bf16_t)f2bf(sd[r]); }
    float den[4];
#pragma unroll
    for (int r = 0; r < 4; ++r) { float d = dsum[r] + inter[r] * accn[r]; d += __shfl_xor(d, 1); d += __shfl_xor(d, 2); d += __shfl_xor(d, 4); d += __shfl_xor(d, 8); den[r] = d; }
    f32x4 acco[8];
#pragma unroll
    for (int vb = 0; vb < 8; ++vb) { acco[vb] = (f32x4){0.f, 0.f, 0.f, 0.f};
#pragma unroll
        for (int ks = 0; ks < 4; ++ks) { const bf16x8 bc = *(const LAS bf16x8*)(Cs + (16 * vb + fr) * RS + (32 * ks + 8 * g) * 2); acco[vb] = __builtin_amdgcn_mfma_f32_16x16x32_bf16(aq[ks], bc, acco[vb], 0, 0, 0); }
#pragma unroll
        for (int r = 0; r < 4; ++r) acco[vb][r] *= inter[r]; }
    __syncthreads();
#pragma unroll
    for (int ks = 0; ks < 4; ++ks) {
        if (2 * ks <= w) { const bf16x8 as_ = *(const LAS bf16x8*)(Qs + (16 * w + fr) * RS + (32 * ks + 8 * g) * 2);
#pragma unroll
            for (int vb = 0; vb < 8; ++vb) { const bf16x8 bv = tr2(Vs + (32 * ks + 8 * g + q) * RS + (16 * vb + 4 * pp) * 2); acco[vb] = __builtin_amdgcn_mfma_f32_16x16x32_bf16(as_, bv, acco[vb], 0, 0, 0); } } }
#pragma unroll
    for (int r = 0; r < 4; ++r) { const int tl = 16 * w + 4 * g + r; const float rinv = 1.f / fmaxf(fabsf(den[r]), __expf(negm[tl]));
        float ss = 0.f;
#pragma unroll
        for (int vb = 0; vb < 8; ++vb) { const float hv = acco[vb][r] * rinv; acco[vb][r] = hv; ss += hv * hv; }
        ss += __shfl_xor(ss, 1); ss += __shfl_xor(ss, 2); ss += __shfl_xor(ss, 4); ss += __shfl_xor(ss, 8);
        const float sc = rsqrtf(ss * (1.f / 128.f) + EPS);
        const bf16_t* pr = PROJ + (size_t)(rowbase + tl) * NPROJ + h * 128; bf16_t* yo = YC + (size_t)(b * 2048 + 128 * (c - 1) + tl) * 1024 + 512 + h * 128;
#pragma unroll
        for (int vb = 0; vb < 8; ++vb) { const int col = 16 * vb + fr; const float o = bf2f(pr[3584 + col]), z = bf2f(pr[4096 + col]);
            yo[col] = (bf16_t)f2bf(acco[vb][r] * sc * p.mh_gain[h * 128 + col] * sigmoidf_(o) * siluf_(z)); } }
    __syncthreads();
}

__global__ void __launch_bounds__(512, 2) fwd_megakernel(Params p) {
    extern __shared__ __attribute__((aligned(16))) unsigned char lds_raw[];
    LAS unsigned char* lds = (LAS unsigned char*)lds_raw;
    const int tid = threadIdx.x, lane = tid & 63, wave = __builtin_amdgcn_readfirstlane(tid >> 6);
    if (p.ws == nullptr) cg::this_grid().sync();
    volatile LAS unsigned* misc = (volatile LAS unsigned*)(lds + LDS_MISC);
    if (tid < 16) misc[tid] = 0u;
    __syncthreads();
    const XcdBarrier bar = xcd_barrier_post((unsigned*)(p.ws + W_BAR), misc);
    phase0(p, lds, tid, lane, wave);
    xcd_barrier(bar);
    { pg8::Gemm g{(const pg8::bf16_t*)(p.ws + W_XN), (const pg8::bf16_t*)(p.ws + W_WTIN), MPAD, NPROJ, DM}; pg8::StaticOrder S; S.init(MPAD, NPROJ, (int)gridDim.x, (int)blockIdx.x);
      pg8::EpiBf16 E{(pg8::bf16_t*)(p.ws + W_PROJ), NPROJ};
      pg8::gemm_phase<pg8::EpiBf16, pg8::StaticOrder, false>((PG8_LAS unsigned char*)lds, g, S, E, nullptr);
      if (wave == 0) for (int bh = (int)gridDim.x - 1 - (int)blockIdx.x; bh < 32; bh += (int)gridDim.x) seq_scan(p, bh, lane); }
    xcd_barrier(bar);
    for (int it = blockIdx.x; it < 544 + 81 + 512; it += gridDim.x) {
        if (it < 544) p2_chunk_local(p, lds, it, tid, lane, wave);
        else if (it < 625) { const int widx = (it - 544) * 8 + wave; if (widx < 648) p2_conv(p, widx, lane); }
        else p2_sample(p, lds, it - 625, tid, lane, wave);
    }
    xcd_barrier(bar);
    phase3(p, tid);
    xcd_barrier(bar);
    for (int it = blockIdx.x; it < 512; it += gridDim.x) p4_chunk_out(p, lds, it, tid, lane, wave);
    xcd_barrier(bar);
    { pg8::Gemm g{(const pg8::bf16_t*)(p.ws + W_XN), (const pg8::bf16_t*)(p.ws + W_WTOUT), MOUT, DM, DM}; pg8::StaticOrder S; S.init(MOUT, DM, (int)gridDim.x, (int)blockIdx.x);
      pg8::EpiRes E{p.x_prompt, p.x_sample, p.out, (float*)(p.ws + W_ROWSS)};
      pg8::gemm_phase<pg8::EpiRes, pg8::StaticOrder, false>((PG8_LAS unsigned char*)lds, g, S, E, nullptr); }
    xcd_barrier(bar);
    { const float* rowss = (const float*)(p.ws + W_ROWSS);
      for (int r = blockIdx.x * 8 + wave; r < MOUT; r += gridDim.x * 8) { const float sc = rsqrtf(rowss[r] * (1.f / 1024.f) + EPS); f32x4* o = (f32x4*)(p.out + (size_t)r * 1024);
#pragma unroll
          for (int j = 0; j < 4; ++j) { const f32x4 g = ((const f32x4*)p.fin_gain)[lane + 64 * j]; o[lane + 64 * j] = o[lane + 64 * j] * sc * g; } } }
}

extern "C" void kernel_launch(void* const* d_in, const int* in_sizes, int n_in, void* d_out, int out_size, void* d_ws, size_t ws_size, hipStream_t stream) {
    static int ready = 0;
    if (!ready) {
        if (n_in != 15 || ws_size < W_END) { fprintf(stderr, "kernel_launch: unexpected n_in %d or ws_size %zu (< %zu)\n", n_in, ws_size, (size_t)W_END); ready = -1; return; }
        if (hipFuncSetAttribute((const void*)fwd_megakernel, hipFuncAttributeMaxDynamicSharedMemorySize, LDS_BYTES) != hipSuccess) { fprintf(stderr, "kernel_launch: hipFuncSetAttribute failed\n"); ready = -1; return; }
        ready = 1;
    }
    if (ready < 0) return;
    Params p{};
    p.x_prompt = (const float*)d_in[0]; p.x_sample = (const float*)d_in[1]; p.st_conv = (const float*)d_in[2]; p.st_c = (const float*)d_in[3]; p.st_n = (const float*)d_in[4]; p.st_m = (const float*)d_in[5];
    p.meta = (const float*)d_in[6]; p.norm_gain = (const float*)d_in[7]; p.w_in = (const float*)d_in[8]; p.conv_w = (const float*)d_in[9]; p.b_ig = (const float*)d_in[10]; p.b_fg = (const float*)d_in[11];
    p.mh_gain = (const float*)d_in[12]; p.w_out = (const float*)d_in[13]; p.fin_gain = (const float*)d_in[14];
    p.out = (float*)d_out; p.ws = (unsigned char*)d_ws;
    if (hipMemsetAsync((unsigned char*)d_ws + W_BAR, 0, 16384, stream) != hipSuccess) { fprintf(stderr, "kernel_launch: memset failed\n"); return; }
    void* args[] = {&p};
    const hipError_t e = hipLaunchCooperativeKernel((const void*)fwd_megakernel, dim3(256), dim3(512), args, LDS_BYTES, stream);
    if (e != hipSuccess) fprintf(stderr, "kernel_launch: cooperative launch failed: %s\n", hipGetErrorString(e));
}
```

```cpp
#include <hip/hip_runtime.h>
#include <hip/hip_cooperative_groups.h>
#include <cstdio>
namespace cg = cooperative_groups;
namespace pg8 {
#define PG8_LAS __attribute__((address_space(3)))
typedef unsigned short bf16_t;
typedef short bf16x8 __attribute__((ext_vector_type(8)));
typedef float f32x4 __attribute__((ext_vector_type(4)));
typedef unsigned u32x4 __attribute__((ext_vector_type(4)));
constexpr int BM = 256, BK = 64, HALF = 128, HTB = HALF * BK * 2  , STAGE_BYTES = 8 * HTB, NXCD = 8, WGM = 8;

__host__ __device__ __forceinline__ int lds_byte(int r, int c) { const int st = (r >> 4) * 2 + (c >> 5), rr = r & 15, cc = c & 31, ob = rr * 64 + cc * 2; return st * 1024 + (ob ^ (((ob >> 9) & 1) << 5)); }
__host__ __device__ __forceinline__ void stage_rc(int b, int& R, int& C) { const int st = b / 1024, sb = b % 1024, swz = sb ^ (((sb >> 9) & 1) << 5); R = (st >> 1) * 16 + swz / 64; C = (st & 1) * 32 + (swz % 64) / 2; }
__host__ __device__ __forceinline__ int perm32(int rho) { const int n = rho >> 4, i = rho & 15; return 8 * (i >> 2) + 4 * n + (i & 3); }

struct Unit { int pm, pn; };
struct Gemm { const bf16_t* A; const bf16_t* Bt; int M, N, K; };

struct StaticOrder {
    int nM, nN, nwg, G, c;
    __host__ __device__ void init(int M, int N, int G_, int c_) { nM = M / BM; nN = N / BM; nwg = nM * nN; G = G_; c = c_; }
    __host__ __device__ bool next(int i, Unit& u) const {
        const long L = (long)i * G + c; if (L >= nwg) return false;
        int wgid = (int)L; { const int q = nwg / NXCD, r = nwg % NXCD, xcd = wgid % NXCD, off = wgid / NXCD; wgid = (xcd < r ? xcd * (q + 1) : r * (q + 1) + (xcd - r) * q) + off; }
        const int nig = WGM * nN, gid = wgid / nig, fm = gid * WGM, gsz = (nM - fm) < WGM ? (nM - fm) : WGM;
        u.pm = fm + ((wgid % nig) % gsz); u.pn = (wgid % nig) / gsz; return true;
    }
    __device__ __forceinline__ void a_ready(const Unit&) const {}
    __device__ __forceinline__ void done(const Unit&) const {}
};
__device__ __forceinline__ unsigned cvt_pk_bf16(float lo, float hi) { unsigned r; asm volatile("v_cvt_pk_bf16_f32 %0, %1, %2" : "=v"(r) : "v"(lo), "v"(hi)); return r; }
struct EpiBf16 {
    static constexpr bool PERM = true, AFTER_DRAIN = false;
    bf16_t* O; int ldc;
    __device__ __forceinline__ void operator()(const f32x4 (&acc)[2][2][4][2], const Unit& u, int wr, int wc, int fr, int fq) const {
        const int row0 = u.pm * BM + wr * 64 + fr, col0 = u.pn * BM + wc * 32 + 8 * fq;
#pragma unroll
        for (int ai = 0; ai < 2; ++ai)
#pragma unroll
            for (int m = 0; m < 4; ++m) { bf16_t* rowp = O + (size_t)(row0 + ai * HALF + m * 16) * ldc + col0;
#pragma unroll
                for (int bj = 0; bj < 2; ++bj) { const f32x4 v0 = acc[ai][bj][m][0], v1 = acc[ai][bj][m][1];
                    u32x4 w; w.x = cvt_pk_bf16(v0[0], v0[1]); w.y = cvt_pk_bf16(v0[2], v0[3]); w.z = cvt_pk_bf16(v1[0], v1[1]); w.w = cvt_pk_bf16(v1[2], v1[3]);
                    *(u32x4*)(rowp + bj * HALF) = w; } }
    }
};
struct EpiRes {
    static constexpr bool PERM = false, AFTER_DRAIN = false;
    const float* xp; const float* xs; float* out; float* rowss;
    __device__ __forceinline__ void operator()(const f32x4 (&acc)[2][2][4][2], const Unit& u, int wr, int wc, int fr, int fq) const {
        const int row0 = u.pm * BM + wr * 64 + fr, col0 = u.pn * BM + wc * 32 + 4 * fq;
#pragma unroll
        for (int ai = 0; ai < 2; ++ai)
#pragma unroll
            for (int m = 0; m < 4; ++m) { const int r = row0 + ai * HALF + m * 16;
                const float* xrow = (r < 16384) ? xp + (size_t)r * 1024 : xs + (size_t)(r - 16384) * 1024; float* orow = out + (size_t)r * 1024; float ss = 0.f;
#pragma unroll
                for (int bj = 0; bj < 2; ++bj)
#pragma unroll
                    for (int n = 0; n < 2; ++n) { const int c = col0 + bj * HALF + n * 16; const f32x4 v = acc[ai][bj][m][n] + *(const f32x4*)(xrow + c); *(f32x4*)(orow + c) = v;
                        ss += (v[0] * v[0] + v[1] * v[1]) + (v[2] * v[2] + v[3] * v[3]); }
                ss += __shfl_xor(ss, 16); ss += __shfl_xor(ss, 32);
                if (fq == 0) __hip_atomic_fetch_add(rowss + r, ss, __ATOMIC_RELAXED, __HIP_MEMORY_SCOPE_AGENT);
                asm volatile("" ::: "memory"); }
    }
};

template <class Epi, class Sched, bool STAMP = false>
__device__ __forceinline__ void gemm_phase(PG8_LAS unsigned char* lds, const Gemm g, const Sched& S, const Epi& E, unsigned long long* stamps) {
    const int tid = threadIdx.x, wid = __builtin_amdgcn_readfirstlane(tid >> 6), lane = tid & 63, wr = wid >> 2, wc = wid & 3, fr = lane & 15, fq = lane >> 4;
    const int K = g.K, nt = K / BK;
    int ts_lo = 0, ts_hi = 0, nts = 0; const unsigned long long rt_entry = STAMP ? (unsigned long long)wall_clock64() : 0ull;
#define PG8_STAMP() do { if (STAMP && wid == 0 && nts < 64) { const unsigned long long _c = (unsigned long long)clock64(); \
        ts_lo = (lane == nts) ? (int)(unsigned)_c : ts_lo; ts_hi = (lane == nts) ? (int)(unsigned)(_c >> 32) : ts_hi; ++nts; } } while (0)
    PG8_STAMP();
    unsigned voffA[2], voffB[2];
#pragma unroll
    for (int i = 0; i < 2; ++i) { int R, C; stage_rc(tid * 16 + i * 8192, R, C); const int Rb = Epi::PERM ? ((R & ~31) + perm32(R & 31)) : R;
        voffA[i] = (unsigned)(R * K + C) * 2u; voffB[i] = (unsigned)(Rb * K + C) * 2u; }
    const size_t kstep = (size_t)(BK * 2);
    const size_t hstep = (size_t)HALF * K * 2;
    const size_t tstep = 2 * hstep;
    const unsigned ldsw = (unsigned)wid * 1024u;
    const int aoff = lds_byte(wr * 64 + fr, fq * 8), boff = lds_byte(wc * 32 + fr, fq * 8);
#define PG8_SA(b, h) (((b) * 2 + (h)) * HTB)
#define PG8_SB(b, h) ((4 + (b) * 2 + (h)) * HTB)
#define PG8_STAGE(bufoff, gbase, voff) do { _Pragma("unroll") for (int _i = 0; _i < 2; ++_i) \
        __builtin_amdgcn_global_load_lds((const unsigned*)((const char*)(gbase) + (voff)[_i]), (PG8_LAS unsigned*)(lds + (bufoff) + ldsw + _i * 8192), 16, 0, 0); } while (0)
#define PG8_LDA(dst, b, h) do { _Pragma("unroll") for (int m = 0; m < 4; ++m) _Pragma("unroll") for (int k = 0; k < 2; ++k) dst[m][k] = *(const PG8_LAS bf16x8*)(lds + PG8_SA(b, h) + aoff + m * 2048 + k * 1024); } while (0)
#define PG8_LDB(dst, b, h) do { _Pragma("unroll") for (int n = 0; n < 2; ++n) _Pragma("unroll") for (int k = 0; k < 2; ++k) dst[n][k] = *(const PG8_LAS bf16x8*)(lds + PG8_SB(b, h) + boff + n * 2048 + k * 1024); } while (0)
#define PG8_MMA(ai, bj, At, Bt) do { __builtin_amdgcn_s_setprio(1); _Pragma("unroll") for (int m = 0; m < 4; ++m) _Pragma("unroll") for (int n = 0; n < 2; ++n) _Pragma("unroll") for (int k = 0; k < 2; ++k) \
        acc[ai][bj][m][n] = __builtin_amdgcn_mfma_f32_16x16x32_bf16(Bt[n][k], At[m][k], acc[ai][bj][m][n], 0, 0, 0); __builtin_amdgcn_s_setprio(0); } while (0)
#define PG8_WAIT_V(n) asm volatile("s_waitcnt vmcnt(" #n ")" ::: "memory")
#define PG8_WAIT_L(n) asm volatile("s_waitcnt lgkmcnt(" #n ")" ::: "memory")
#define PG8_BAR __builtin_amdgcn_s_barrier()
#define PG8_SCHED __builtin_amdgcn_sched_barrier(0)
    Unit cur, nxt; int ui = 0;
    if (!S.next(0, cur)) return;
    f32x4 acc[2][2][4][2];
#pragma unroll
    for (int a = 0; a < 2; ++a)
#pragma unroll
        for (int b = 0; b < 2; ++b)
#pragma unroll
            for (int m = 0; m < 4; ++m)
#pragma unroll
                for (int n = 0; n < 2; ++n) acc[a][b][m][n] = (f32x4){0.f, 0.f, 0.f, 0.f};
    bf16x8 At[4][2], B0[2][2], B1[2][2];
    const char* cA = (const char*)g.A + (size_t)cur.pm * tstep; const char* cB = (const char*)g.Bt + (size_t)cur.pn * tstep;
    S.a_ready(cur);
    PG8_STAGE(PG8_SB(0, 0), cB, voffB); PG8_STAGE(PG8_SA(0, 0), cA, voffA); PG8_STAGE(PG8_SB(0, 1), cB + hstep, voffB); PG8_STAGE(PG8_SA(0, 1), cA + hstep, voffA);
    if (wr == 1) PG8_BAR;
    PG8_WAIT_V(4); PG8_BAR;
    PG8_STAGE(PG8_SB(1, 0), cB + kstep, voffB); PG8_STAGE(PG8_SA(1, 0), cA + kstep, voffA); PG8_STAGE(PG8_SB(1, 1), cB + hstep + kstep, voffB);
    PG8_WAIT_V(6); PG8_BAR;
    PG8_STAMP();
    for (;;) {
        const bool has_next = S.next(ui + 1, nxt);
        const char* nA = has_next ? (const char*)g.A + (size_t)nxt.pm * tstep : cA; const char* nB = has_next ? (const char*)g.Bt + (size_t)nxt.pn * tstep : cB;
        for (int t = 0; t < nt; t += 2) {
            const bool last = (t == nt - 2);
            const char* a1 = cA + (size_t)(t + 1) * kstep;
            const char* a2 = last ? nA : cA + (size_t)(t + 2) * kstep; const char* b2 = last ? nB : cB + (size_t)(t + 2) * kstep;
            const char* a3 = a2 + kstep; const char* b3 = b2 + kstep;
            if (last && has_next) S.a_ready(nxt);
            PG8_LDB(B0, 0, 0); PG8_SCHED; PG8_LDA(At, 0, 0); PG8_STAGE(PG8_SA(1, 1), a1 + hstep, voffA);
            PG8_WAIT_L(8); PG8_BAR; PG8_WAIT_L(0); PG8_MMA(0, 0, At, B0); PG8_BAR; PG8_SCHED;
            PG8_LDB(B1, 0, 1); PG8_STAGE(PG8_SB(0, 0), b2, voffB);
            PG8_BAR; PG8_WAIT_L(0); PG8_MMA(0, 1, At, B1); PG8_BAR;
            PG8_LDA(At, 0, 1); PG8_STAGE(PG8_SA(0, 0), a2, voffA);
            PG8_BAR; PG8_WAIT_L(0); PG8_MMA(1, 0, At, B0); PG8_BAR; PG8_SCHED;
            PG8_STAGE(PG8_SB(0, 1), b2 + hstep, voffB);
            PG8_WAIT_V(6); PG8_BAR; PG8_MMA(1, 1, At, B1); PG8_BAR;
            PG8_LDB(B0, 1, 0); PG8_SCHED; PG8_LDA(At, 1, 0); PG8_STAGE(PG8_SA(0, 1), a2 + hstep, voffA);
            PG8_WAIT_L(8); PG8_BAR; PG8_WAIT_L(0); PG8_MMA(0, 0, At, B0); PG8_BAR; PG8_SCHED;
            PG8_LDB(B1, 1, 1); PG8_STAGE(PG8_SB(1, 0), b3, voffB);
            PG8_BAR; PG8_WAIT_L(0); PG8_MMA(0, 1, At, B1); PG8_BAR;
            PG8_LDA(At, 1, 1); PG8_STAGE(PG8_SA(1, 0), a3, voffA);
            PG8_BAR; PG8_WAIT_L(0); PG8_MMA(1, 0, At, B0); PG8_BAR; PG8_SCHED;
            PG8_STAGE(PG8_SB(1, 1), b3 + hstep, voffB);
            PG8_WAIT_V(6); PG8_BAR; PG8_MMA(1, 1, At, B1); PG8_BAR;
        }
        PG8_STAMP();
        if constexpr (!Epi::AFTER_DRAIN) { E(acc, cur, wr, wc, fr, fq); S.done(cur); }
        PG8_STAMP();
        if (!has_next) break;
#pragma unroll
        for (int a = 0; a < 2; ++a)
#pragma unroll
            for (int b = 0; b < 2; ++b)
#pragma unroll
                for (int m = 0; m < 4; ++m)
#pragma unroll
                    for (int n = 0; n < 2; ++n) acc[a][b][m][n] = (f32x4){0.f, 0.f, 0.f, 0.f};
        cur = nxt; cA = nA; cB = nB; ++ui;
    }
    PG8_WAIT_V(0);
    if (wr == 0) PG8_BAR;
    PG8_BAR;
    if constexpr (Epi::AFTER_DRAIN) { E.fused(acc, cur, wr, wc, fr, fq, lds, wid, lane); S.done(cur); }
    PG8_STAMP();
    if (STAMP && wid == 0) { stamps[lane] = lane < nts ? (((unsigned long long)(unsigned)ts_hi << 32) | (unsigned)ts_lo) : 0ull;
        if (lane == 62) stamps[62] = rt_entry; if (lane == 63) stamps[63] = (unsigned long long)wall_clock64(); }
#undef PG8_STAMP
#undef PG8_SA
#undef PG8_SB
#undef PG8_STAGE
#undef PG8_LDA
#undef PG8_LDB
#undef PG8_MMA
#undef PG8_WAIT_V
#undef PG8_WAIT_L
#undef PG8_BAR
#undef PG8_SCHED
}
}

#define LAS __attribute__((address_space(3)))
typedef unsigned short bf16_t;
typedef short bf16x8 __attribute__((ext_vector_type(8)));
typedef short s16x4 __attribute__((ext_vector_type(4)));
typedef float f32x4 __attribute__((ext_vector_type(4)));
typedef unsigned u32x4 __attribute__((ext_vector_type(4)));
typedef unsigned u32x2 __attribute__((ext_vector_type(2)));

constexpr int DM = 1024, TP = 2064, NPROW = 8 * TP  , NROW = NPROW + 1024  , MPAD = 17664, NPROJ = 4608, LDW = 4616, MOUT = 17408;
constexpr int NCH = 17;
constexpr int RS = 272;
constexpr int TILE_B = 128 * RS;
constexpr int LDS_MISC = 147456;
constexpr int LDS_BYTES = 147456 + 64;
constexpr float KSCALE = 0.08838834764831845f;
constexpr float EPS = 1e-6f;
constexpr size_t O_YS = 16777216, O_CONVP = 17825792, O_CP = 17833984, O_NP = 18358272, O_MP = 18362368, O_CONVS = 18362400, O_CS = 18493472, O_NS = 26882080, O_MS = 26947616;
constexpr size_t W_WTIN = 0, W_WTOUT = 9437184, W_XN = 11534336, W_G = 47710208, W_A = 48271360, W_M = W_A + 264192, W_B = W_M + 264192, W_MLOC = 49063936, W_NLOC = 49068032,
                 W_NST = 49346560, W_ROWSS = 49625088, W_PROJ = 49694720, W_LLOC = 212486144, W_CST = 248137728, W_BAR = 265963520, W_END = W_BAR + 16384;

struct Params {
    const float *x_prompt, *x_sample, *st_conv, *st_c, *st_n, *st_m, *meta, *norm_gain, *w_in, *conv_w, *b_ig, *b_fg, *mh_gain, *w_out, *fin_gain;
    float* out; unsigned char* ws;
};

template <int C> __device__ __forceinline__ float dppf(float v) { return __int_as_float(__builtin_amdgcn_update_dpp(0, __float_as_int(v), C, 0xF, 0xF, true)); }
__device__ __forceinline__ float row16_sum(float v) { v += dppf<0xB1>(v); v += dppf<0x4E>(v); v += dppf<0x141>(v); v += dppf<0x140>(v); return v; }
__device__ __forceinline__ float wave_sum(float v) { v = row16_sum(v); v += __shfl_xor(v, 16); v += __shfl_xor(v, 32); return v; }
__device__ __forceinline__ float wave_max(float v) {
    v = fmaxf(v, dppf<0xB1>(v)); v = fmaxf(v, dppf<0x4E>(v)); v = fmaxf(v, dppf<0x141>(v)); v = fmaxf(v, dppf<0x140>(v)); v = fmaxf(v, __shfl_xor(v, 16)); v = fmaxf(v, __shfl_xor(v, 32)); return v;
}
__device__ __forceinline__ unsigned f2bf(float f) { unsigned u = __float_as_uint(f); return (u + 0x7fffu + ((u >> 16) & 1u)) >> 16; }
__device__ __forceinline__ unsigned pk2(float lo, float hi) { return f2bf(lo) | (f2bf(hi) << 16); }
__device__ __forceinline__ float bf2f(unsigned b) { return __uint_as_float(b << 16); }
__device__ __forceinline__ float bflo(unsigned w) { return __uint_as_float(w << 16); }
__device__ __forceinline__ float bfhi(unsigned w) { return __uint_as_float(w & 0xffff0000u); }
__device__ __forceinline__ float sigmoidf_(float x) { return 1.f / (1.f + __expf(-x)); }
__device__ __forceinline__ float siluf_(float x) { return x / (1.f + __expf(-x)); }
__device__ __forceinline__ bf16x8 tr2(LAS unsigned char* p0) {
    const s16x4 lo = __builtin_amdgcn_ds_read_tr16_b64_v4i16((LAS s16x4*)p0);
    const s16x4 hi = __builtin_amdgcn_ds_read_tr16_b64_v4i16((LAS s16x4*)(p0 + 4 * RS));
    return __builtin_shufflevector(lo, hi, 0, 1, 2, 3, 4, 5, 6, 7);
}

#define XB_TMO      128
#define XB_XCNT(j)  (256  + 64 * (j))
#define XB_XSUB(j)  (1280 + 64 * (j))
#define XB_XGEN(j)  (2304 + 64 * (j))
#define XB_TOP      3328
#define XB_TOPGEN   3392
#define XCD_BAR_WORDS 3456
#define XB_SPIN_CAP (1u << 18)

__device__ __forceinline__ unsigned xb_ld(unsigned* p)              { return __hip_atomic_load(p, __ATOMIC_RELAXED, __HIP_MEMORY_SCOPE_AGENT); }
__device__ __forceinline__ unsigned xb_add(unsigned* p, unsigned v) { return __hip_atomic_fetch_add(p, v, __ATOMIC_RELAXED, __HIP_MEMORY_SCOPE_AGENT); }
__device__ __forceinline__ unsigned xb_xcc_id() { return (unsigned)__builtin_amdgcn_s_getreg((3 << 11) | 20) & 0xFu; }
#define XB_SPIN(cond, bar) do { unsigned _sp = 0; while (cond) { __builtin_amdgcn_s_sleep(1); \
    if ((++_sp & 255u) == 0u) { if (xb_ld(&(bar)[XB_TMO])) break; if (_sp > XB_SPIN_CAP) { atomicAdd(&(bar)[XB_TMO], 1u); break; } } } } while (0)

struct XcdBarrier {
    unsigned* bar; unsigned x;
    volatile LAS unsigned* st;
};

__device__ __forceinline__ XcdBarrier xcd_barrier_post(unsigned* bar, volatile LAS unsigned* st) {
    XcdBarrier b; b.bar = bar; b.x = xb_xcc_id(); b.st = st;
    if (threadIdx.x == 0) (void)xb_add(&bar[XB_XCNT(b.x)], 1u);
    return b;
}
__device__ __forceinline__ void xcd_barrier_complete(unsigned* bar, unsigned x, unsigned& nloc, unsigned& nx) {
    const unsigned G = gridDim.x * gridDim.y * gridDim.z;
    unsigned sum, cnt, mine, sp = 0u;
    for (;;) {
        sum = 0u; cnt = 0u; mine = 0u;
#pragma unroll
        for (unsigned j = 0; j < 16; ++j) { const unsigned c = xb_ld(&bar[XB_XCNT(j)]); sum += c; cnt += (c > 0u) ? 1u : 0u; mine = (j == x) ? c : mine; }
        if (sum == G) break;
        __builtin_amdgcn_s_sleep(1);
        if ((++sp & 255u) == 0u) { if (xb_ld(&bar[XB_TMO])) break; if (sp > XB_SPIN_CAP) { atomicAdd(&bar[XB_TMO], 1u); break; } }
    }
    nloc = mine > 0u ? mine : 1u; nx = cnt > 0u ? cnt : 1u;
}

__device__ __forceinline__ void xcd_barrier(const XcdBarrier& b) {
    asm volatile("s_waitcnt vmcnt(0)" ::: "memory");
    __syncthreads();
    if (threadIdx.x == 0) {
        unsigned* bar = b.bar;
        __builtin_amdgcn_s_waitcnt(0);
        unsigned nloc = b.st[0], nx = b.st[1];
        if (nloc == 0u) { xcd_barrier_complete(bar, b.x, nloc, nx); b.st[0] = nloc; b.st[1] = nx; }
        const unsigned old = xb_add(&bar[XB_XSUB(b.x)], 1u);
        const unsigned gen = old / nloc;
        if (old + 1u == (gen + 1u) * nloc) {
            __builtin_amdgcn_fence(__ATOMIC_RELEASE, "agent");
            asm volatile("s_waitcnt vmcnt(0)" ::: "memory");
            const unsigned og = xb_add(&bar[XB_TOP], 1u);
            const unsigned tg = og / nx;
            if (og + 1u == (tg + 1u) * nx) xb_add(&bar[XB_TOPGEN], 1u);
            else XB_SPIN(xb_ld(&bar[XB_TOPGEN]) == tg, bar);
            __builtin_amdgcn_fence(__ATOMIC_ACQUIRE, "agent");
            xb_add(&bar[XB_XGEN(b.x)], 1u);
            asm volatile("s_waitcnt vmcnt(0)" ::: "memory");
        } else {
            XB_SPIN(xb_ld(&bar[XB_XGEN(b.x)]) == gen, bar);
            __builtin_amdgcn_fence(__ATOMIC_ACQUIRE, "agent");
            asm volatile("s_waitcnt vmcnt(0)" ::: "memory");
        }
    }
    __syncthreads();
}

__device__ __forceinline__ void p0_transpose_item(const float* W, int ldw, int nblk, bf16_t* WT, int K, LAS float* scr, int item, int lane) {
    const int kb = item / nblk, nb = item % nblk, k0 = 64 * kb, n0 = 32 * nb;
#pragma unroll 8
    for (int i = 0; i < 32; ++i) { const int kk = 2 * i + (lane >> 5); scr[kk * 33 + (lane & 31)] = W[(size_t)(k0 + kk) * ldw + n0 + (lane & 31)]; }
    asm volatile("s_waitcnt lgkmcnt(0)" ::: "memory");
    const int c = lane & 7;
#pragma unroll
    for (int j = 0; j < 4; ++j) { const int n = (lane >> 3) + 8 * j; const LAS float* s = scr + (8 * c) * 33 + n;
        u32x4 o; o.x = pk2(s[0 * 33], s[1 * 33]); o.y = pk2(s[2 * 33], s[3 * 33]); o.z = pk2(s[4 * 33], s[5 * 33]); o.w = pk2(s[6 * 33], s[7 * 33]);
        *(u32x4*)(WT + (size_t)(n0 + n) * K + k0 + 8 * c) = o; }
    asm volatile("s_waitcnt lgkmcnt(0)" ::: "memory");
}

__device__ __forceinline__ void phase0(const Params& p, LAS unsigned char* lds, int tid, int lane, int wave) {
    LAS float* gwl = (LAS float*)lds;
    LAS float* scr = (LAS float*)(lds + 32768) + wave * (64 * 33);
    for (int i = tid; i < 8192; i += 512) { const int k = i >> 3, j = i & 7; gwl[j * 1024 + k] = p.w_in[(size_t)k * LDW + NPROJ + j]; }
    __syncthreads();
    const int gw = blockIdx.x * 8 + wave, NGW = gridDim.x * 8;
    float* rowss = (float*)(p.ws + W_ROWSS);
    for (int i = blockIdx.x * 512 + tid; i < MOUT; i += gridDim.x * 512) rowss[i] = 0.f;
    bf16_t* XN = (bf16_t*)(p.ws + W_XN);
    for (int i = blockIdx.x * 512 + tid; i < 16384; i += gridDim.x * 512) ((u32x4*)(XN + (size_t)NROW * 1024))[i] = (u32x4){0u, 0u, 0u, 0u};
    for (int it = gw; it < 2304 + 512; it += NGW) {
        if (it < 2304) p0_transpose_item(p.w_in, LDW, 144, (bf16_t*)(p.ws + W_WTIN), 1024, scr, it, lane);
        else p0_transpose_item(p.w_out, 1024, 32, (bf16_t*)(p.ws + W_WTOUT), 1024, scr, it - 2304, lane);
    }
    float* G = (float*)(p.ws + W_G);
    for (int r0 = gw; r0 < NROW; r0 += 4 * NGW) {
        f32x4 v[4][4];
#pragma unroll
        for (int k = 0; k < 4; ++k) { const int rq = r0 + k * NGW, r = rq < NROW ? rq : r0; const float* src;
            if (r < NPROW) { const int b = r / TP, t = r - b * TP; src = (t < 16) ? p.meta + t * 1024 : p.x_prompt + ((size_t)b * 2048 + (t - 16)) * 1024; }
            else src = p.x_sample + (size_t)(r - NPROW) * 1024;
#pragma unroll
            for (int j = 0; j < 4; ++j) v[k][j] = ((const f32x4*)src)[lane + 64 * j]; }
#pragma unroll
        for (int k = 0; k < 4; ++k) { const int r = r0 + k * NGW; if (r < NROW) {
            float ss = 0.f;
#pragma unroll
            for (int j = 0; j < 4; ++j) ss += (v[k][j][0] * v[k][j][0] + v[k][j][1] * v[k][j][1]) + (v[k][j][2] * v[k][j][2] + v[k][j][3] * v[k][j][3]);
            const float rstd = rsqrtf(wave_sum(ss) * (1.f / 1024.f) + EPS);
#pragma unroll
            for (int j = 0; j < 4; ++j) { const f32x4 g = ((const f32x4*)p.norm_gain)[lane + 64 * j]; v[k][j] = v[k][j] * rstd * g;
                u32x2 o; o.x = pk2(v[k][j][0], v[k][j][1]); o.y = pk2(v[k][j][2], v[k][j][3]); ((u32x2*)(XN + (size_t)r * 1024))[lane + 64 * j] = o; }
            float s[8];
#pragma unroll
            for (int q = 0; q < 8; ++q) { s[q] = 0.f;
#pragma unroll
                for (int j = 0; j < 4; ++j) { const f32x4 w = *(const LAS f32x4*)(gwl + q * 1024 + 4 * (lane + 64 * j)); s[q] += (v[k][j][0] * w[0] + v[k][j][1] * w[1]) + (v[k][j][2] * w[2] + v[k][j][3] * w[3]); } }
            const bool h5 = (lane & 32) != 0, h4 = (lane & 16) != 0, h3 = (lane & 8) != 0;
            float t4[4], u2[2];
#pragma unroll
            for (int i = 0; i < 4; ++i) { const float keep = h5 ? s[4 + i] : s[i], send = h5 ? s[i] : s[4 + i]; t4[i] = keep + __shfl_xor(send, 32); }
#pragma unroll
            for (int i = 0; i < 2; ++i) { const float keep = h4 ? t4[2 + i] : t4[i], send = h4 ? t4[i] : t4[2 + i]; u2[i] = keep + __shfl_xor(send, 16); }
            float wv; { const float keep = h3 ? u2[1] : u2[0], send = h3 ? u2[0] : u2[1]; wv = keep + dppf<0x140>(send); }
            wv += dppf<0xB1>(wv); wv += dppf<0x4E>(wv); wv += dppf<0x141>(wv);
            if ((lane & 7) == 0) { const int j = lane >> 3;
                if (j < 4) G[(size_t)r * 8 + j] = wv + p.b_ig[j];
                else { const float x = wv + p.b_fg[j - 4]; G[(size_t)r * 8 + j] = fminf(x, 0.f) - log1pf(expf(-fabsf(x))); } }
        } }
    }
}

__device__ __forceinline__ void seq_scan(const Params& p, int bh, int lane) {
    const float* G = (const float*)(p.ws + W_G); float* A = (float*)(p.ws + W_A) + bh * TP; float* M = (float*)(p.ws + W_M) + bh * TP; float* Bc = (float*)(p.ws + W_B) + bh * TP;
    const int b = bh >> 2, h = bh & 3; float cB = 0.f, cM = 0.f;
    for (int it = 0; it < 33; ++it) { const int t = it * 64 + lane; const bool valid = t < TP; const size_t row = (size_t)b * TP + (valid ? t : 0);
        const float lf = valid ? G[row * 8 + 4 + h] : 0.f, ig = valid ? G[row * 8 + h] : -INFINITY;
        float s = lf;
#pragma unroll
        for (int o = 1; o < 64; o <<= 1) { const float n = __shfl_up(s, o); if (lane >= o) s += n; }
        const float Bt = cB + s; const float a = valid ? ig - Bt : -INFINITY; float m = a;
#pragma unroll
        for (int o = 1; o < 64; o <<= 1) { const float n = __shfl_up(m, o); if (lane >= o) m = fmaxf(m, n); }
        const float Mt = fmaxf(cM, m);
        if (valid) { A[t] = a; M[t] = Mt; Bc[t] = Bt; }
        cB = __shfl(Bt, 63); cM = __shfl(Mt, 63); }
}

__device__ __forceinline__ void p2_chunk_local(const Params& p, LAS unsigned char* lds, int it, int tid, int lane, int wave) {
    LAS unsigned char* Ks = lds; LAS unsigned char* Vs = lds + TILE_B; LAS float* wl = (LAS float*)(lds + 2 * TILE_B);
    const int bh = it / NCH, c = it - bh * NCH, b = bh >> 2, h = bh & 3, t0 = c ? 16 + 128 * (c - 1) : 0, L = c ? 128 : 16;
    const float* Aseq = (const float*)(p.ws + W_A) + bh * TP + t0;
    const float a0 = lane < L ? Aseq[lane] : -INFINITY, a1 = lane + 64 < L ? Aseq[lane + 64] : -INFINITY;
    const float Mloc = wave_max(fmaxf(a0, a1));
    if (wave == 0) { wl[lane] = lane < L ? __expf(a0 - Mloc) : 0.f; wl[lane + 64] = lane + 64 < L ? __expf(a1 - Mloc) : 0.f; }
    const bf16_t* PROJ = (const bf16_t*)(p.ws + W_PROJ);
#pragma unroll
    for (int i = 0; i < 4; ++i) { const int idx = tid + 512 * i, s = idx >> 4, ch = idx & 15;
        const bf16_t* pr = PROJ + (size_t)(b * TP + t0 + s) * NPROJ + h * 128 + ch * 8;
        const u32x4 kv = *(const u32x4*)(pr + 2560); u32x4 vv = *(const u32x4*)(pr + 3072);
        const float w = s < L ? __expf(Aseq[s] - Mloc) : 0.f;
        vv.x = pk2(bflo(vv.x) * w, bfhi(vv.x) * w); vv.y = pk2(bflo(vv.y) * w, bfhi(vv.y) * w); vv.z = pk2(bflo(vv.z) * w, bfhi(vv.z) * w); vv.w = pk2(bflo(vv.w) * w, bfhi(vv.w) * w);
        *(LAS u32x4*)(Ks + s * RS + ch * 16) = kv; *(LAS u32x4*)(Vs + s * RS + ch * 16) = vv; }
    __syncthreads();
    const int fr = lane & 15, g = lane >> 4, q = fr >> 2, pp = fr & 3;
    bf16x8 af[4];
#pragma unroll
    for (int ks = 0; ks < 4; ++ks) af[ks] = tr2(Vs + (32 * ks + 8 * g + q) * RS + (16 * wave + 4 * pp) * 2);
    float* LT = (float*)(p.ws + W_LLOC) + (size_t)it * 16384;
#pragma unroll
    for (int nb = 0; nb < 8; ++nb) { f32x4 acc = {0.f, 0.f, 0.f, 0.f};
#pragma unroll
        for (int ks = 0; ks < 4; ++ks) { const bf16x8 bk = tr2(Ks + (32 * ks + 8 * g + q) * RS + (16 * nb + 4 * pp) * 2); acc = __builtin_amdgcn_mfma_f32_16x16x32_bf16(af[ks], bk, acc, 0, 0, 0); }
#pragma unroll
        for (int r = 0; r < 4; ++r) LT[(16 * wave + 4 * g + r) * 128 + 16 * nb + fr] = acc[r] * KSCALE; }
    if (tid < 128) { float s = 0.f;
        for (int ss = 0; ss < 128; ++ss) s += wl[ss] * bf2f(*(const LAS bf16_t*)(Ks + ss * RS + tid * 2));
        ((float*)(p.ws + W_NLOC))[(size_t)it * 128 + tid] = s * KSCALE; }
    if (tid == 0) ((float*)(p.ws + W_MLOC))[it] = Mloc;
    __syncthreads();
}

__device__ __forceinline__ void ld8(const bf16_t* src, float (&o)[8]) { const u32x4 r = *(const u32x4*)src; o[0] = bflo(r.x); o[1] = bfhi(r.x); o[2] = bflo(r.y); o[3] = bfhi(r.y); o[4] = bflo(r.z); o[5] = bfhi(r.z); o[6] = bflo(r.w); o[7] = bfhi(r.w); }
__device__ __forceinline__ void ld8f(const float* src, float (&o)[8]) { const f32x4 a = *(const f32x4*)src, b = *(const f32x4*)(src + 4); o[0] = a[0]; o[1] = a[1]; o[2] = a[2]; o[3] = a[3]; o[4] = b[0]; o[5] = b[1]; o[6] = b[2]; o[7] = b[3]; }
__device__ __forceinline__ void st8f(float* dst, const float (&o)[8]) { *(f32x4*)dst = (f32x4){o[0], o[1], o[2], o[3]}; *(f32x4*)(dst + 4) = (f32x4){o[4], o[5], o[6], o[7]}; }
__device__ __forceinline__ void up8(const u32x4 r, float (&o)[8]) { o[0] = bflo(r.x); o[1] = bfhi(r.x); o[2] = bflo(r.y); o[3] = bfhi(r.y); o[4] = bflo(r.z); o[5] = bfhi(r.z); o[6] = bflo(r.w); o[7] = bfhi(r.w); }
__device__ __forceinline__ void p2_conv(const Params& p, int widx, int lane) {
    const bf16_t* PROJ = (const bf16_t*)(p.ws + W_PROJ); bf16_t* YC = (bf16_t*)(p.ws + W_XN);
    const int c0 = lane * 8; const bool sample = widx >= 2064;
    int rowbase, t0, sb = 0, b = 0;
    if (!sample) { b = widx / 258; t0 = 8 * (widx - b * 258); rowbase = b * TP; }
    else { sb = widx - 2064; t0 = 0; rowbase = NPROW + sb * 8; }
    float w0[8], w1[8], w2[8], u1[8], u2[8];
    ld8f(p.conv_w + c0, w0); ld8f(p.conv_w + 512 + c0, w1); ld8f(p.conv_w + 1024 + c0, w2);
    if (sample) { ld8f(p.st_conv + (size_t)sb * 1024 + c0, u2); ld8f(p.st_conv + (size_t)sb * 1024 + 512 + c0, u1); }
    else if (t0 == 0) {
#pragma unroll
        for (int i = 0; i < 8; ++i) { u1[i] = 0.f; u2[i] = 0.f; } }
    else { float gc[8], hc[8], gc1[8], hc1[8];
        const bf16_t* pr = PROJ + (size_t)(rowbase + t0 - 2) * NPROJ + c0; ld8(pr + 512, gc); ld8(pr + 1024, hc); ld8(pr + NPROJ + 512, gc1); ld8(pr + NPROJ + 1024, hc1);
#pragma unroll
        for (int i = 0; i < 8; ++i) { u2[i] = gc[i] * hc[i]; u1[i] = gc1[i] * hc1[i]; } }
#pragma unroll
    for (int half = 0; half < 2; ++half) {
        u32x4 rgb[4], rgc[4], rhc[4], rzc[4];
#pragma unroll
        for (int k = 0; k < 4; ++k) { const bf16_t* pr = PROJ + (size_t)(rowbase + t0 + half * 4 + k) * NPROJ + c0;
            rgb[k] = *(const u32x4*)pr; rgc[k] = *(const u32x4*)(pr + 512); rhc[k] = *(const u32x4*)(pr + 1024); rzc[k] = *(const u32x4*)(pr + 1536); }
#pragma unroll
        for (int k = 0; k < 4; ++k) { const int t = t0 + half * 4 + k;
            float gb[8], gc[8], hc[8], zc[8], u[8], y[8]; up8(rgb[k], gb); up8(rgc[k], gc); up8(rhc[k], hc); up8(rzc[k], zc);
#pragma unroll
            for (int i = 0; i < 8; ++i) { u[i] = gc[i] * hc[i]; const float yc = w0[i] * u2[i] + w1[i] * u1[i] + w2[i] * u[i]; y[i] = gb[i] * yc * siluf_(zc[i]); }
            u32x4 o; o.x = pk2(y[0], y[1]); o.y = pk2(y[2], y[3]); o.z = pk2(y[4], y[5]); o.w = pk2(y[6], y[7]);
            if (sample) { *(u32x4*)(YC + (size_t)(16384 + sb * 8 + t) * 1024 + c0) = o; if (t >= 6) st8f(p.out + O_CONVS + (size_t)sb * 1024 + (t - 6) * 512 + c0, u); }
            else { if (t >= 16) *(u32x4*)(YC + (size_t)(b * 2048 + t - 16) * 1024 + c0) = o; if (t >= TP - 2) st8f(p.out + O_CONVP + (size_t)b * 1024 + (t - (TP - 2)) * 512 + c0, u); }
#pragma unroll
            for (int i = 0; i < 8; ++i) { u2[i] = u1[i]; u1[i] = u[i]; } } }
}

__device__ __forceinline__ void p2_sample(const Params& p, LAS unsigned char* lds, int si, int tid, int lane, int wave) {
    LAS float* ql = (LAS float*)lds; LAS float* kl = ql + 1024; LAS float* vl = kl + 1024; LAS float* sdl = vl + 1024; LAS float* qnl = sdl + 64; LAS float* red = qnl + 64;
    const int sb = si >> 2, h = si & 3, rowbase = NPROW + sb * 8; const size_t sh = (size_t)sb * 4 + h;
    const float* G = (const float*)(p.ws + W_G); const bf16_t* PROJ = (const bf16_t*)(p.ws + W_PROJ); bf16_t* YC = (bf16_t*)(p.ws + W_XN);
    const int dg = tid >> 5, v4 = tid & 31; const size_t coff = (sh * 128 + dg * 8) * 128 + v4 * 4;
    const float* Cp = p.st_c + coff; float* Cn = p.out + O_CS + coff;
    f32x4 Cv[8];
#pragma unroll
    for (int i = 0; i < 8; ++i) Cv[i] = *(const f32x4*)(Cp + i * 128);
    const float mprev = p.st_m[sh];
    float a[8], M[8], bc[8];
    { float run = 0.f, Mr = mprev;
#pragma unroll
      for (int t = 0; t < 8; ++t) { run += G[(size_t)(rowbase + t) * 8 + 4 + h]; bc[t] = run; a[t] = G[(size_t)(rowbase + t) * 8 + h] - run; Mr = fmaxf(Mr, a[t]); M[t] = Mr; } }
    float Mt = M[0], bt = bc[0];
#pragma unroll
    for (int t = 1; t < 8; ++t) { Mt = (wave == t) ? M[t] : Mt; bt = (wave == t) ? bc[t] : bt; }
    if (tid < 384) { const int mat = tid >> 7, rem = tid & 127, t = rem >> 4, ch = rem & 15; float x[8];
        ld8(PROJ + (size_t)(rowbase + t) * NPROJ + 2048 + mat * 512 + h * 128 + ch * 8, x);
        const float sc = (mat == 1) ? KSCALE : 1.f; LAS float* dst = ql + mat * 1024 + t * 128 + ch * 8;
        *(LAS f32x4*)dst = (f32x4){x[0] * sc, x[1] * sc, x[2] * sc, x[3] * sc}; *(LAS f32x4*)(dst + 4) = (f32x4){x[4] * sc, x[5] * sc, x[6] * sc, x[7] * sc}; }
    __syncthreads();
    const float* nprev = p.st_n + sh * 128;
    { const int t = wave; const float q0 = ql[t * 128 + lane], q1 = ql[t * 128 + lane + 64];
      const float qn = wave_sum(q0 * nprev[lane] + q1 * nprev[lane + 64]);
#pragma unroll
      for (int s = 0; s < 8; ++s) { const float d = wave_sum(q0 * kl[s * 128 + lane] + q1 * kl[s * 128 + lane + 64]); const float val = (s <= t) ? d * __expf(a[s] - Mt) : 0.f; if (lane == 0) sdl[t * 8 + s] = val; }
      if (lane == 0) qnl[t] = qn; }
    __syncthreads();
    const float decay = __expf(mprev - M[7]);
    float wS[8];
#pragma unroll
    for (int s = 0; s < 8; ++s) wS[s] = __expf(a[s] - M[7]);
    {
#pragma unroll
      for (int t = 0; t < 8; ++t) { f32x4 pt = {0.f, 0.f, 0.f, 0.f};
#pragma unroll
          for (int i = 0; i < 8; ++i) pt += ql[t * 128 + dg * 8 + i] * Cv[i];
          *(LAS f32x4*)(red + (dg * 8 + t) * 128 + v4 * 4) = pt; }
#pragma unroll
      for (int i = 0; i < 8; ++i) { f32x4 cn = decay * Cv[i];
#pragma unroll
          for (int s = 0; s < 8; ++s) cn += (wS[s] * kl[s * 128 + dg * 8 + i]) * *(const LAS f32x4*)(vl + s * 128 + v4 * 4);
          *(f32x4*)(Cn + i * 128) = cn; } }
    __syncthreads();
    { const int t = wave; const float inter = __expf(mprev - Mt), mt = bt + Mt;
      float n0 = 0.f, n1 = 0.f;
#pragma unroll
      for (int dg = 0; dg < 16; ++dg) { n0 += red[(dg * 8 + t) * 128 + lane]; n1 += red[(dg * 8 + t) * 128 + lane + 64]; }
      n0 *= inter; n1 *= inter; float den = inter * qnl[t];
#pragma unroll
      for (int s = 0; s < 8; ++s) { const float sd = sdl[t * 8 + s]; n0 += sd * vl[s * 128 + lane]; n1 += sd * vl[s * 128 + lane + 64]; den += sd; }
      const float dd = fmaxf(fabsf(den), __expf(-mt)); const float h0 = n0 / dd, h1 = n1 / dd;
      const float sc = rsqrtf(wave_sum(h0 * h0 + h1 * h1) * (1.f / 128.f) + EPS);
      const bf16_t* pr = PROJ + (size_t)(rowbase + t) * NPROJ + h * 128;
      const float o0 = bf2f(pr[3584 + lane]), o1 = bf2f(pr[3584 + lane + 64]), z0 = bf2f(pr[4096 + lane]), z1 = bf2f(pr[4096 + lane + 64]);
      const float y0 = h0 * sc * p.mh_gain[h * 128 + lane] * sigmoidf_(o0) * siluf_(z0), y1 = h1 * sc * p.mh_gain[h * 128 + lane + 64] * sigmoidf_(o1) * siluf_(z1);
      bf16_t* yo = YC + (size_t)(16384 + sb * 8 + t) * 1024 + 512 + h * 128; yo[lane] = (bf16_t)f2bf(y0); yo[lane + 64] = (bf16_t)f2bf(y1); }
    if (tid < 128) { float nn = decay * nprev[tid];
#pragma unroll
        for (int s = 0; s < 8; ++s) nn += wS[s] * kl[s * 128 + tid];
        p.out[O_NS + sh * 128 + tid] = nn; }
    if (tid == 0) p.out[O_MS + sh] = bc[7] + M[7];
    __syncthreads();
}

__device__ __forceinline__ void phase3(const Params& p, int tid) {
    const float* Mall = (const float*)(p.ws + W_M); const float* MLOC = (const float*)(p.ws + W_MLOC);
    const float* LLOC = (const float*)(p.ws + W_LLOC); bf16_t* CST = (bf16_t*)(p.ws + W_CST);
    const float* NLOC = (const float*)(p.ws + W_NLOC); float* NST = (float*)(p.ws + W_NST);
    for (int e = blockIdx.x * 512 + tid; e < 32 * 4096; e += gridDim.x * 512) {
        const int bh = e >> 12, rem = e & 4095, v = rem >> 5, d4 = rem & 31; const float* Mseq = Mall + bh * TP;
        const size_t off0 = (size_t)(bh * NCH) * 16384 + v * 128 + d4 * 4;
        f32x4 Lv[NCH]; float al[NCH], be[NCH];
#pragma unroll
        for (int c = 0; c < NCH; ++c) Lv[c] = *(const f32x4*)(LLOC + off0 + (size_t)c * 16384);
        { float Eprev = 0.f;
#pragma unroll
          for (int c = 0; c < NCH; ++c) { const float Ec = Mseq[c ? 16 + 128 * c - 1 : 15], Ml = MLOC[bh * NCH + c]; al[c] = __expf(Eprev - Ec); be[c] = __expf(Ml - Ec); Eprev = Ec; } }
        f32x4 st = {0.f, 0.f, 0.f, 0.f};
#pragma unroll
        for (int c = 0; c < NCH; ++c) { u32x2 o; o.x = pk2(st[0], st[1]); o.y = pk2(st[2], st[3]); *(u32x2*)(CST + off0 + (size_t)c * 16384) = o; st = al[c] * st + be[c] * Lv[c]; }
#pragma unroll
        for (int j = 0; j < 4; ++j) p.out[O_CP + ((size_t)bh * 128 + d4 * 4 + j) * 128 + v] = st[j];
        if (e < 32 * 128) {
            const int bh2 = e >> 7, d = e & 127; const float* Mseq2 = Mall + bh2 * TP; float nl[NCH], al2[NCH], be2[NCH];
#pragma unroll
            for (int c = 0; c < NCH; ++c) nl[c] = NLOC[(size_t)(bh2 * NCH + c) * 128 + d];
            { float Eprev = 0.f;
#pragma unroll
              for (int c = 0; c < NCH; ++c) { const float Ec = Mseq2[c ? 16 + 128 * c - 1 : 15], Ml = MLOC[bh2 * NCH + c]; al2[c] = __expf(Eprev - Ec); be2[c] = __expf(Ml - Ec); Eprev = Ec; } }
            float sn = 0.f;
#pragma unroll
            for (int c = 0; c < NCH; ++c) { NST[(size_t)(bh2 * NCH + c) * 128 + d] = sn; sn = al2[c] * sn + be2[c] * nl[c]; }
            p.out[O_NP + e] = sn;
            if (d == 0) p.out[O_MP + bh2] = ((const float*)(p.ws + W_B))[bh2 * TP + TP - 1] + Mseq2[TP - 1];
        }
    }
}

__device__ __forceinline__ void p4_chunk_out(const Params& p, LAS unsigned char* lds, int it, int tid, int lane, int wave) {
    LAS unsigned char* Qs = lds; LAS unsigned char* Ks = lds + TILE_B; LAS unsigned char* Vs = lds + 2 * TILE_B; LAS unsigned char* Cs = lds + 3 * TILE_B;
    LAS float* al = (LAS float*)(lds + 4 * TILE_B); LAS float* Ml = al + 128; LAS float* negm = Ml + 128; LAS float* nsl = negm + 128;
    const int bh = it >> 4, c = (it & 15) + 1, b = bh >> 2, h = bh & 3, t0 = 16 + 128 * (c - 1), rowbase = b * TP + t0;
    const bf16_t* PROJ = (const bf16_t*)(p.ws + W_PROJ); bf16_t* YC = (bf16_t*)(p.ws + W_XN);
    const bf16_t* CT = (const bf16_t*)(p.ws + W_CST) + (size_t)(bh * NCH + c) * 16384;
    const float* Mseq = (const float*)(p.ws + W_M) + bh * TP;
#pragma unroll
    for (int i = 0; i < 4; ++i) { const int idx = tid + 512 * i, s = idx >> 4, ch = idx & 15;
        const bf16_t* pr = PROJ + (size_t)(rowbase + s) * NPROJ + h * 128 + ch * 8;
        *(LAS u32x4*)(Qs + s * RS + ch * 16) = *(const u32x4*)(pr + 2048); *(LAS u32x4*)(Ks + s * RS + ch * 16) = *(const u32x4*)(pr + 2560);
        *(LAS u32x4*)(Vs + s * RS + ch * 16) = *(const u32x4*)(pr + 3072); *(LAS u32x4*)(Cs + s * RS + ch * 16) = *(const u32x4*)(CT + s * 128 + ch * 8); }
    if (tid < 128) { const float m = Mseq[t0 + tid]; al[tid] = ((const float*)(p.ws + W_A))[bh * TP + t0 + tid]; Ml[tid] = m; negm[tid] = -(((const float*)(p.ws + W_B))[bh * TP + t0 + tid] + m);
        nsl[tid] = ((const float*)(p.ws + W_NST))[(size_t)(bh * NCH + c) * 128 + tid]; }
    const float Eprev = Mseq[t0 - 1];
    __syncthreads();
    const int fr = lane & 15, g = lane >> 4, q = fr >> 2, pp = fr & 3, w = wave;
    bf16x8 aq[4];
#pragma unroll
    for (int ks = 0; ks < 4; ++ks) aq[ks] = *(const LAS bf16x8*)(Qs + (16 * w + fr) * RS + (32 * ks + 8 * g) * 2);
    f32x4 accn = {0.f, 0.f, 0.f, 0.f};
#pragma unroll
    for (int ks = 0; ks < 4; ++ks) { bf16x8 bn;
#pragma unroll
        for (int j = 0; j < 8; ++j) bn[j] = (fr == 0) ? (short)f2bf(nsl[32 * ks + 8 * g + j]) : (short)0;
        accn = __builtin_amdgcn_mfma_f32_16x16x32_bf16(aq[ks], bn, accn, 0, 0, 0); }
    float Mt[4], inter[4], dsum[4];
#pragma unroll
    for (int r = 0; r < 4; ++r) { Mt[r] = Ml[16 * w + 4 * g + r]; inter[r] = __expf(Eprev - Mt[r]); dsum[r] = 0.f; }
#pragma unroll
    for (int nb = 0; nb < 8; ++nb) { float sd[4] = {0.f, 0.f, 0.f, 0.f};
        if (nb <= w) { f32x4 s = {0.f, 0.f, 0.f, 0.f};
#pragma unroll
            for (int ks = 0; ks < 4; ++ks) { const bf16x8 bk = *(const LAS bf16x8*)(Ks + (16 * nb + fr) * RS + (32 * ks + 8 * g) * 2); s = __builtin_amdgcn_mfma_f32_16x16x32_bf16(aq[ks], bk, s, 0, 0, 0); }
            const float as = al[16 * nb + fr]; const int scol = 16 * nb + fr;
#pragma unroll
            for (int r = 0; r < 4; ++r) { const int trow = 16 * w + 4 * g + r; const float val = (scol <= trow) ? s[r] * KSCALE * __expf(as - Mt[r]) : 0.f; dsum[r] += val; sd[r] = val; } }
#pragma unroll
        for (int r = 0; r < 4; ++r) *(LAS bf16_t*)(Qs + (16 * w + 4 * g + r) * RS + (16 * nb + fr) * 2) = (bf16_t)f2bf(sd[r]); }
    float den[4];
#pragma unroll
    for (int r = 0; r < 4; ++r) { float d = dsum[r] + inter[r] * accn[r]; d += __shfl_xor(d, 1); d += __shfl_xor(d, 2); d += __shfl_xor(d, 4); d += __shfl_xor(d, 8); den[r] = d; }
    f32x4 acco[8];
#pragma unroll
    for (int vb = 0; vb < 8; ++vb) { acco[vb] = (f32x4){0.f, 0.f, 0.f, 0.f};
#pragma unroll
        for (int ks = 0; ks < 4; ++ks) { const bf16x8 bc = *(const LAS bf16x8*)(Cs + (16 * vb + fr) * RS + (32 * ks + 8 * g) * 2); acco[vb] = __builtin_amdgcn_mfma_f32_16x16x32_bf16(aq[ks], bc, acco[vb], 0, 0, 0); }
#pragma unroll
        for (int r = 0; r < 4; ++r) acco[vb][r] *= inter[r]; }
    __syncthreads();
#pragma unroll
    for (int ks = 0; ks < 4; ++ks) {
        if (2 * ks <= w) { const bf16x8 as_ = *(const LAS bf16x8*)(Qs + (16 * w + fr) * RS + (32 * ks + 8 * g) * 2);
#pragma unroll
            for (int vb = 0; vb < 8; ++vb) { const bf16x8 bv = tr2(Vs + (32 * ks + 8 * g + q) * RS + (16 * vb + 4 * pp) * 2); acco[vb] = __builtin_amdgcn_mfma_f32_16x16x32_bf16(as_, bv, acco[vb], 0, 0, 0); } } }
#pragma unroll
    for (int r = 0; r < 4; ++r) { const int tl = 16 * w + 4 * g + r; const float rinv = 1.f / fmaxf(fabsf(den[r]), __expf(negm[tl]));
        float ss = 0.f;
#pragma unroll
        for (int vb = 0; vb < 8; ++vb) { const float hv = acco[vb][r] * rinv; acco[vb][r] = hv; ss += hv * hv; }
        ss += __shfl_xor(ss, 1); ss += __shfl_xor(ss, 2); ss += __shfl_xor(ss, 4); ss += __shfl_xor(ss, 8);
        const float sc = rsqrtf(ss * (1.f / 128.f) + EPS);
        const bf16_t* pr = PROJ + (size_t)(rowbase + tl) * NPROJ + h * 128; bf16_t* yo = YC + (size_t)(b * 2048 + 128 * (c - 1) + tl) * 1024 + 512 + h * 128;
#pragma unroll
        for (int vb = 0; vb < 8; ++vb) { const int col = 16 * vb + fr; const float o = bf2f(pr[3584 + col]), z = bf2f(pr[4096 + col]);
            yo[col] = (bf16_t)f2bf(acco[vb][r] * sc * p.mh_gain[h * 128 + col] * sigmoidf_(o) * siluf_(z)); } }
    __syncthreads();
}

__global__ void __launch_bounds__(512, 2) fwd_megakernel(Params p) {
    extern __shared__ __attribute__((aligned(16))) unsigned char lds_raw[];
    LAS unsigned char* lds = (LAS unsigned char*)lds_raw;
    const int tid = threadIdx.x, lane = tid & 63, wave = __builtin_amdgcn_readfirstlane(tid >> 6);
    if (p.ws == nullptr) cg::this_grid().sync();
    volatile LAS unsigned* misc = (volatile LAS unsigned*)(lds + LDS_MISC);
    if (tid < 16) misc[tid] = 0u;
    __syncthreads();
    const XcdBarrier bar = xcd_barrier_post((unsigned*)(p.ws + W_BAR), misc);
    phase0(p, lds, tid, lane, wave);
    xcd_barrier(bar);
    { pg8::Gemm g{(const pg8::bf16_t*)(p.ws + W_XN), (const pg8::bf16_t*)(p.ws + W_WTIN), MPAD, NPROJ, DM}; pg8::StaticOrder S; S.init(MPAD, NPROJ, (int)gridDim.x, (int)blockIdx.x);
      pg8::EpiBf16 E{(pg8::bf16_t*)(p.ws + W_PROJ), NPROJ};
      pg8::gemm_phase<pg8::EpiBf16, pg8::StaticOrder, false>((PG8_LAS unsigned char*)lds, g, S, E, nullptr);
      if (wave == 0) for (int bh = (int)gridDim.x - 1 - (int)blockIdx.x; bh < 32; bh += (int)gridDim.x) seq_scan(p, bh, lane); }
    xcd_barrier(bar);
    for (int widx = blockIdx.x * 8 + wave; widx < 2064 + 128; widx += gridDim.x * 8) p2_conv(p, widx, lane);
    for (int it = blockIdx.x; it < 544 + 512; it += gridDim.x) {
        if (it < 544) p2_chunk_local(p, lds, it, tid, lane, wave);
        else p2_sample(p, lds, it - 544, tid, lane, wave);
    }
    xcd_barrier(bar);
    phase3(p, tid);
    xcd_barrier(bar);
    for (int it = blockIdx.x; it < 512; it += gridDim.x) p4_chunk_out(p, lds, it, tid, lane, wave);
    xcd_barrier(bar);
    { pg8::Gemm g{(const pg8::bf16_t*)(p.ws + W_XN), (const pg8::bf16_t*)(p.ws + W_WTOUT), MOUT, DM, DM}; pg8::StaticOrder S; S.init(MOUT, DM, (int)gridDim.x, (int)blockIdx.x);
      pg8::EpiRes E{p.x_prompt, p.x_sample, p.out, (float*)(p.ws + W_ROWSS)};
      pg8::gemm_phase<pg8::EpiRes, pg8::StaticOrder, false>((PG8_LAS unsigned char*)lds, g, S, E, nullptr); }
    xcd_barrier(bar);
    { const float* rowss = (const float*)(p.ws + W_ROWSS); const int gw = blockIdx.x * 8 + wave, NGW = gridDim.x * 8;
      f32x4 g[4];
#pragma unroll
      for (int j = 0; j < 4; ++j) g[j] = ((const f32x4*)p.fin_gain)[lane + 64 * j];
      for (int r0 = gw; r0 < MOUT; r0 += 4 * NGW) { f32x4 v[4][4]; float sc[4];
#pragma unroll
          for (int k = 0; k < 4; ++k) { const int rq = r0 + k * NGW, r = rq < MOUT ? rq : r0; sc[k] = rowss[r]; const f32x4* o = (const f32x4*)(p.out + (size_t)r * 1024);
#pragma unroll
              for (int j = 0; j < 4; ++j) v[k][j] = o[lane + 64 * j]; }
#pragma unroll
          for (int k = 0; k < 4; ++k) { const int r = r0 + k * NGW; if (r < MOUT) { const float s = rsqrtf(sc[k] * (1.f / 1024.f) + EPS); f32x4* o = (f32x4*)(p.out + (size_t)r * 1024);
#pragma unroll
              for (int j = 0; j < 4; ++j) o[lane + 64 * j] = v[k][j] * s * g[j]; } } } }
}

extern "C" void kernel_launch(void* const* d_in, const int* in_sizes, int n_in, void* d_out, int out_size, void* d_ws, size_t ws_size, hipStream_t stream) {
    static int ready = 0;
    if (!ready) {
        if (n_in != 15 || ws_size < W_END) { fprintf(stderr, "kernel_launch: unexpected n_in %d or ws_size %zu (< %zu)\n", n_in, ws_size, (size_t)W_END); ready = -1; return; }
        if (hipFuncSetAttribute((const void*)fwd_megakernel, hipFuncAttributeMaxDynamicSharedMemorySize, LDS_BYTES) != hipSuccess) { fprintf(stderr, "kernel_launch: hipFuncSetAttribute failed\n"); ready = -1; return; }
        ready = 1;
    }
    if (ready < 0) return;
    Params p{};
    p.x_prompt = (const float*)d_in[0]; p.x_sample = (const float*)d_in[1]; p.st_conv = (const float*)d_in[2]; p.st_c = (const float*)d_in[3]; p.st_n = (const float*)d_in[4]; p.st_m = (const float*)d_in[5];
    p.meta = (const float*)d_in[6]; p.norm_gain = (const float*)d_in[7]; p.w_in = (const float*)d_in[8]; p.conv_w = (const float*)d_in[9]; p.b_ig = (const float*)d_in[10]; p.b_fg = (const float*)d_in[11];
    p.mh_gain = (const float*)d_in[12]; p.w_out = (const float*)d_in[13]; p.fin_gain = (const float*)d_in[14];
    p.out = (float*)d_out; p.ws = (unsigned char*)d_ws;
    if (hipMemsetAsync((unsigned char*)d_ws + W_BAR, 0, 16384, stream) != hipSuccess) { fprintf(stderr, "kernel_launch: memset failed\n"); return; }
    void* args[] = {&p};
    const hipError_t e = hipLaunchCooperativeKernel((const void*)fwd_megakernel, dim3(256), dim3(512), args, LDS_BYTES, stream);
    if (e != hipSuccess) fprintf(stderr, "kernel_launch: cooperative launch failed: %s\n", hipGetErrorString(e));
}
```
